# Optimizing an MI355X kernel written in HIP

```python
import jax, jax.numpy as jnp
from jax import lax
import numpy as np

D_MODEL = 1024
BATCH = 32
SEQ = 2048
DEPTH = 4

CHUNK = 64
Q_BLOCK = 128
EPS = 1e-6
NEG_INF = -1e30

MLA_HEADS = 8
QK_NOPE = 64
QK_ROPE = 32
V_HEAD = 64
Q_LORA = 256
KV_LORA = 128
ROPE_THETA = 10000.0
MLA_WIDTH = MLA_HEADS * V_HEAD

POOL_WINDOWS = (2, 4, 8, 16)
POOL_GROUPS = 4
POOL_GROUP_DIM = 64
POOL_WIDTH = POOL_GROUPS * POOL_GROUP_DIM
POOL_MAX_WIN = 16

SGU_BLOCK = 128
SGU_GROUPS = 4
SGU_GROUP_DIM = 64
SGU_WIDTH = SGU_GROUPS * SGU_GROUP_DIM

CONV_K = 3
CONV_WIDTH = 256

N_BRANCH = 4
D_FF = ((8 * D_MODEL + 3 * 256 - 1) // (3 * 256)) * 256

IN_SIZES = (Q_LORA, KV_LORA, QK_ROPE, POOL_WIDTH, SGU_WIDTH, SGU_WIDTH,
            CONV_WIDTH, CONV_WIDTH, CONV_WIDTH, N_BRANCH * D_MODEL)
IN_WIDTH = sum(IN_SIZES)

kernel_name = "hybrid_gated_mla_pool_sgu_conv_trunk"


def rmsnorm(x, g):
    xf = x.astype(jnp.float32)
    y = xf * lax.rsqrt(jnp.mean(xf * xf, axis=-1, keepdims=True) + EPS)
    return (y * g.astype(jnp.float32)).astype(x.dtype)


def split_cols(p):
    out = []
    o = 0
    for n in IN_SIZES:
        out.append(p[..., o:o + n])
        o += n
    return out


def rope_tables(seq, dtype):
    inv = ROPE_THETA ** (-jnp.arange(0, QK_ROPE, 2, dtype=jnp.float32) / QK_ROPE)
    ang = jnp.arange(seq, dtype=jnp.float32)[:, None] * inv[None, :]
    return jnp.cos(ang).astype(dtype), jnp.sin(ang).astype(dtype)


def apply_rope(x, cos, sin):
    half = x.shape[-1] // 2
    x1, x2 = x[..., :half], x[..., half:]
    return jnp.concatenate([x1 * cos - x2 * sin, x2 * cos + x1 * sin], axis=-1)


def mla_branch(c_q, c_kv, k_r, g_cq, g_ckv, w_uq, w_ukv, cos, sin):
    B, S, _ = c_q.shape
    q = (rmsnorm(c_q, g_cq) @ w_uq).reshape(B, S, MLA_HEADS, QK_NOPE + QK_ROPE)
    q_nope = q[..., :QK_NOPE]
    q_rope = apply_rope(q[..., QK_NOPE:], cos[:, None, :], sin[:, None, :])
    kv = (rmsnorm(c_kv, g_ckv) @ w_ukv).reshape(B, S, MLA_HEADS, QK_NOPE + V_HEAD)
    k_nope, v = kv[..., :QK_NOPE], kv[..., QK_NOPE:]
    k_rope = apply_rope(k_r, cos, sin)
    scale = (QK_NOPE + QK_ROPE) ** -0.5
    chunk_id = jnp.arange(S) // CHUNK
    outs = []
    for blk in range(S // Q_BLOCK):
        q0 = blk * Q_BLOCK
        kend = q0 + Q_BLOCK
        s = (jnp.einsum('bqhd,bkhd->bhqk', q_nope[:, q0:kend], k_nope[:, :kend])
             + jnp.einsum('bqhr,bkr->bhqk', q_rope[:, q0:kend], k_rope[:, :kend]))
        s = s.astype(jnp.float32) * scale
        mask = chunk_id[q0:kend, None] >= chunk_id[None, :kend]
        s = jnp.where(mask[None, None], s, NEG_INF)
        p = jax.nn.softmax(s, axis=-1).astype(v.dtype)
        outs.append(jnp.einsum('bhqk,bkhd->bqhd', p, v[:, :kend]))
    return jnp.concatenate(outs, axis=1).reshape(B, S, MLA_WIDTH)


def pool_branch(z, w_grp, scale):
    B, S, _ = z.shape
    zg = z.reshape(B, S, POOL_GROUPS, POOL_GROUP_DIM).astype(jnp.float32)
    csp = jnp.pad(jnp.cumsum(zg, axis=1), ((0, 0), (POOL_MAX_WIN, 0), (0, 0), (0, 0)))
    t = jnp.arange(S)
    outs = []
    for g, w in enumerate(POOL_WINDOWS):
        win_sum = (csp[:, POOL_MAX_WIN:POOL_MAX_WIN + S, g]
                   - csp[:, POOL_MAX_WIN - w:POOL_MAX_WIN - w + S, g])
        count = jnp.minimum(t + 1, w).astype(jnp.float32)
        outs.append(win_sum / count[None, :, None] - zg[:, :, g])
    pooled = jnp.stack(outs, axis=2).astype(z.dtype)
    mixed = jnp.einsum('bsgc,gcd->bsgd', pooled, w_grp)
    return mixed.reshape(B, S, POOL_WIDTH) * scale


def sgu_branch(u, v, g_v, w_s, b_s):
    B, S, _ = u.shape
    n = S // SGU_BLOCK
    vn = rmsnorm(v, g_v).reshape(B, n, SGU_BLOCK, SGU_GROUPS, SGU_GROUP_DIM)
    pos_chunk = jnp.arange(SGU_BLOCK) // CHUNK
    mask = pos_chunk[:, None] >= pos_chunk[None, :]
    w = jnp.where(mask[None], w_s, 0)
    mixed = jnp.einsum('gij,bnjgc->bnigc', w, vn) + b_s.T[None, None, :, :, None]
    return u * mixed.reshape(B, S, SGU_WIDTH)


def conv_branch(b_gate, c_gate, x_in, w_conv):
    z = c_gate * x_in
    y = lax.conv_general_dilated(z, w_conv, window_strides=(1,),
                                 padding=[(CONV_K - 1, 0)],
                                 dimension_numbers=('NWC', 'WIO', 'NWC'),
                                 feature_group_count=CONV_WIDTH)
    return b_gate * y


def setup_inputs(seed: int = 0) -> dict:
    key = jax.random.key(seed)
    ks = iter(jax.random.split(key, 32))

    def nrm(shape, fan_in):
        return jax.random.normal(next(ks), shape, jnp.float32) * (fan_in ** -0.5)

    def gain(shape):
        return 1.0 + 0.1 * jax.random.normal(next(ks), shape, jnp.float32)

    L = DEPTH
    return {
        "x": jax.random.normal(next(ks), (BATCH, SEQ, D_MODEL), jnp.float32),
        "w_in": nrm((L, D_MODEL, IN_WIDTH), D_MODEL),
        "g_pre_mix": gain((L, D_MODEL)),
        "g_cq": gain((L, Q_LORA)),
        "g_ckv": gain((L, KV_LORA)),
        "w_uq": nrm((L, Q_LORA, MLA_HEADS * (QK_NOPE + QK_ROPE)), Q_LORA),
        "w_ukv": nrm((L, KV_LORA, MLA_HEADS * (QK_NOPE + V_HEAD)), KV_LORA),
        "pool_w": nrm((L, POOL_GROUPS, POOL_GROUP_DIM, POOL_GROUP_DIM), POOL_GROUP_DIM),
        "pool_scale": gain((L, POOL_WIDTH)),
        "g_sgu_v": gain((L, SGU_WIDTH)),
        "sgu_w": nrm((L, SGU_GROUPS, SGU_BLOCK, SGU_BLOCK), SGU_BLOCK),
        "sgu_b": gain((L, SGU_GROUPS, SGU_BLOCK)),
        "conv_w": nrm((L, CONV_K, 1, CONV_WIDTH), CONV_K),
        "w_br_a": nrm((L, MLA_WIDTH, D_MODEL), MLA_WIDTH),
        "w_br_b": nrm((L, POOL_WIDTH, D_MODEL), POOL_WIDTH),
        "w_br_c": nrm((L, SGU_WIDTH, D_MODEL), SGU_WIDTH),
        "w_br_d": nrm((L, CONV_WIDTH, D_MODEL), CONV_WIDTH),
        "w_out": nrm((L, D_MODEL, D_MODEL), D_MODEL),
        "g_post_mix": gain((L, D_MODEL)),
        "g_pre_ffn": gain((L, D_MODEL)),
        "w_ffn_gate": nrm((L, D_MODEL, D_FF), D_MODEL),
        "w_ffn_up": nrm((L, D_MODEL, D_FF), D_MODEL),
        "w_ffn_down": nrm((L, D_FF, D_MODEL), D_FF),
        "g_post_ffn": gain((L, D_MODEL)),
    }


def reference(x, w_in, g_pre_mix, g_cq, g_ckv, w_uq, w_ukv, pool_w, pool_scale,
              g_sgu_v, sgu_w, sgu_b, conv_w, w_br_a, w_br_b, w_br_c, w_br_d,
              w_out, g_post_mix, g_pre_ffn, w_ffn_gate, w_ffn_up, w_ffn_down,
              g_post_ffn):
    B, S, D = x.shape
    cos, sin = rope_tables(S, x.dtype)
    for l in range(DEPTH):
        h = rmsnorm(x, g_pre_mix[l])
        (c_q, c_kv, k_r, p_in, s_u, s_v, cv_b, cv_c, cv_x,
         gate_logits) = split_cols(h @ w_in[l])
        y_a = mla_branch(c_q, c_kv, k_r, g_cq[l], g_ckv[l], w_uq[l], w_ukv[l], cos, sin) @ w_br_a[l]
        y_b = pool_branch(p_in, pool_w[l], pool_scale[l]) @ w_br_b[l]
        y_c = sgu_branch(s_u, s_v, g_sgu_v[l], sgu_w[l], sgu_b[l]) @ w_br_c[l]
        y_d = conv_branch(cv_b, cv_c, cv_x, conv_w[l]) @ w_br_d[l]
        gates = jax.nn.sigmoid(gate_logits.astype(jnp.float32)).astype(x.dtype)
        gates = gates.reshape(B, S, N_BRANCH, D)
        merged = (gates[:, :, 0] * y_a + gates[:, :, 1] * y_b
                  + gates[:, :, 2] * y_c + gates[:, :, 3] * y_d)
        x = x + rmsnorm(merged @ w_out[l], g_post_mix[l])
        h = rmsnorm(x, g_pre_ffn[l])
        f = (jax.nn.silu(h @ w_ffn_gate[l]) * (h @ w_ffn_up[l])) @ w_ffn_down[l]
        x = x + rmsnorm(f, g_post_ffn[l])
    return x
```

```cpp
#include <hip/hip_runtime.h>
#include <hip/hip_cooperative_groups.h>
#include <cstdio>
#include <cstdint>
namespace cg = cooperative_groups;

namespace pg8 {
#define PG8_LAS __attribute__((address_space(3)))
typedef unsigned short bf16_t;
typedef short bf16x8 __attribute__((ext_vector_type(8)));
typedef float f32x4 __attribute__((ext_vector_type(4)));
typedef unsigned u32x4 __attribute__((ext_vector_type(4)));
constexpr int BM = 256, BK = 64, HALF = 128, HTB = HALF * BK * 2, STAGE_BYTES = 8 * HTB, NXCD = 8, WGM = 8;

__host__ __device__ __forceinline__ int lds_byte(int r, int c) { const int st = (r >> 4) * 2 + (c >> 5), rr = r & 15, cc = c & 31, ob = rr * 64 + cc * 2; return st * 1024 + (ob ^ (((ob >> 9) & 1) << 5)); }
__host__ __device__ __forceinline__ void stage_rc(int b, int& R, int& C) { const int st = b / 1024, sb = b % 1024, swz = sb ^ (((sb >> 9) & 1) << 5); R = (st >> 1) * 16 + swz / 64; C = (st & 1) * 32 + (swz % 64) / 2; }
__host__ __device__ __forceinline__ int perm32(int rho) { const int n = rho >> 4, i = rho & 15; return 8 * (i >> 2) + 4 * n + (i & 3); }

struct Unit { int pm, pn; };
struct Gemm { const bf16_t* A; const bf16_t* Bt; int M, N, K, lda, ldb; };

struct StaticOrder {
    int nM, nN, nwg, G, c;
    __host__ __device__ void init(int M, int N, int G_, int c_) { nM = M / BM; nN = N / BM; nwg = nM * nN; G = G_; c = c_; }
    __host__ __device__ bool next(int i, Unit& u) const {
        const long L = (long)i * G + c; if (L >= nwg) return false;
        int wgid = (int)L; { const int q = nwg / NXCD, r = nwg % NXCD, xcd = wgid % NXCD, off = wgid / NXCD; wgid = (xcd < r ? xcd * (q + 1) : r * (q + 1) + (xcd - r) * q) + off; }
        const int nig = WGM * nN, gid = wgid / nig, fm = gid * WGM, gsz = (nM - fm) < WGM ? (nM - fm) : WGM;
        u.pm = fm + ((wgid % nig) % gsz); u.pn = (wgid % nig) / gsz; return true;
    }
};

typedef float f32x2_t __attribute__((ext_vector_type(2))); typedef __bf16 bf16x2_t __attribute__((ext_vector_type(2)));
__device__ __forceinline__ unsigned cvt_pk_bf16(float lo, float hi) { f32x2_t v = {lo, hi}; bf16x2_t b = __builtin_convertvector(v, bf16x2_t); return __builtin_bit_cast(unsigned, b); }

template <class Epi, bool ALIGN_EPI>
__device__ __forceinline__ void gemm_phase(PG8_LAS unsigned char* lds, const Gemm g, const StaticOrder& S, const Epi& E, int tid) {
    const int wid = __builtin_amdgcn_readfirstlane(tid >> 6), lane = tid & 63, wr = wid >> 2, wc = wid & 3, fr = lane & 15, fq = lane >> 4;
    const int K = g.K, nt = K / BK;
    unsigned voffA[2], voffB[2];
#pragma unroll
    for (int i = 0; i < 2; ++i) { int R, C; stage_rc(tid * 16 + i * 8192, R, C); const int Rb = (R & ~31) + perm32(R & 31);
        voffA[i] = (unsigned)(R * g.lda + C) * 2u; voffB[i] = (unsigned)(Rb * g.ldb + C) * 2u; }
    const size_t kstep = (size_t)(BK * 2);
    const size_t hstepA = (size_t)HALF * g.lda * 2, hstepB = (size_t)HALF * g.ldb * 2;
    const size_t tstepA = 2 * hstepA, tstepB = 2 * hstepB;
    const unsigned ldsw = (unsigned)wid * 1024u;
    const int aoff = lds_byte(wr * 64 + fr, fq * 8), boff = lds_byte(wc * 32 + fr, fq * 8);
#define PG8_SA(b, h) (((b) * 2 + (h)) * HTB)
#define PG8_SB(b, h) ((4 + (b) * 2 + (h)) * HTB)
#define PG8_STAGE(bufoff, gbase, voff) do { _Pragma("unroll") for (int _i = 0; _i < 2; ++_i) \
        __builtin_amdgcn_global_load_lds((const unsigned*)((const char*)(gbase) + (voff)[_i]), (PG8_LAS unsigned*)(lds + (bufoff) + ldsw + _i * 8192), 16, 0, 0); } while (0)
#define PG8_LDA(dst, b, h) do { _Pragma("unroll") for (int m = 0; m < 4; ++m) _Pragma("unroll") for (int k = 0; k < 2; ++k) dst[m][k] = *(const PG8_LAS bf16x8*)(lds + PG8_SA(b, h) + aoff + m * 2048 + k * 1024); } while (0)
#define PG8_LDB(dst, b, h) do { _Pragma("unroll") for (int n = 0; n < 2; ++n) _Pragma("unroll") for (int k = 0; k < 2; ++k) dst[n][k] = *(const PG8_LAS bf16x8*)(lds + PG8_SB(b, h) + boff + n * 2048 + k * 1024); } while (0)
#define PG8_MMA(ai, bj, At, Bt) do { __builtin_amdgcn_s_setprio(1); _Pragma("unroll") for (int m = 0; m < 4; ++m) _Pragma("unroll") for (int n = 0; n < 2; ++n) _Pragma("unroll") for (int k = 0; k < 2; ++k) \
        acc[ai][bj][m][n] = __builtin_amdgcn_mfma_f32_16x16x32_bf16(Bt[n][k], At[m][k], acc[ai][bj][m][n], 0, 0, 0); __builtin_amdgcn_s_setprio(0); } while (0)
#define PG8_WAIT_V(n) asm volatile("s_waitcnt vmcnt(" #n ")" ::: "memory")
#define PG8_WAIT_L(n) asm volatile("s_waitcnt lgkmcnt(" #n ")" ::: "memory")
#define PG8_BAR __builtin_amdgcn_s_barrier()
#define PG8_SCHED __builtin_amdgcn_sched_barrier(0)
    Unit cur, nxt; int ui = 0;
    if (!S.next(0, cur)) return;
    f32x4 acc[2][2][4][2];
#pragma unroll
    for (int a = 0; a < 2; ++a)
#pragma unroll
        for (int b = 0; b < 2; ++b)
#pragma unroll
            for (int m = 0; m < 4; ++m)
#pragma unroll
                for (int n = 0; n < 2; ++n) acc[a][b][m][n] = (f32x4){0.f, 0.f, 0.f, 0.f};
    bf16x8 At[4][2], B0[2][2], B1[2][2];
    const char* cA = (const char*)g.A + (size_t)cur.pm * tstepA; const char* cB = (const char*)g.Bt + (size_t)cur.pn * tstepB;
    PG8_STAGE(PG8_SB(0, 0), cB, voffB); PG8_STAGE(PG8_SB(0, 1), cB + hstepB, voffB); PG8_STAGE(PG8_SA(0, 0), cA, voffA); PG8_STAGE(PG8_SA(0, 1), cA + hstepA, voffA);
    if (wr == 1) PG8_BAR;
    PG8_WAIT_V(2); PG8_BAR;
    PG8_STAGE(PG8_SB(1, 0), cB + kstep, voffB); PG8_STAGE(PG8_SA(1, 0), cA + kstep, voffA); PG8_STAGE(PG8_SB(1, 1), cB + hstepB + kstep, voffB);
    PG8_WAIT_V(6); PG8_BAR;
    for (;;) {
        const bool has_next = S.next(ui + 1, nxt);
        const char* nA = has_next ? (const char*)g.A + (size_t)nxt.pm * tstepA : cA; const char* nB = has_next ? (const char*)g.Bt + (size_t)nxt.pn * tstepB : cB;
        for (int t = 0; t < nt; t += 2) {
            const bool last = (t == nt - 2);
            const char* a1 = cA + (size_t)(t + 1) * kstep;
            const char* a2 = last ? nA : cA + (size_t)(t + 2) * kstep; const char* b2 = last ? nB : cB + (size_t)(t + 2) * kstep;
            const char* a3 = a2 + kstep; const char* b3 = b2 + kstep;
            PG8_LDB(B0, 0, 0); PG8_LDB(B1, 0, 1); PG8_SCHED; PG8_LDA(At, 0, 0); PG8_STAGE(PG8_SA(1, 1), a1 + hstepA, voffA);
            PG8_WAIT_V(8); PG8_WAIT_L(0); PG8_BAR; PG8_MMA(0, 0, At, B0); PG8_MMA(0, 1, At, B1); PG8_BAR; PG8_SCHED;
            PG8_LDA(At, 0, 1); PG8_STAGE(PG8_SB(0, 0), b2, voffB); PG8_STAGE(PG8_SB(0, 1), b2 + hstepB, voffB); PG8_STAGE(PG8_SA(0, 0), a2, voffA);
            PG8_WAIT_V(8); PG8_WAIT_L(0); PG8_BAR; PG8_MMA(1, 0, At, B0); PG8_MMA(1, 1, At, B1); PG8_BAR; PG8_SCHED;
            PG8_LDB(B0, 1, 0); PG8_LDB(B1, 1, 1); PG8_SCHED; PG8_LDA(At, 1, 0); PG8_STAGE(PG8_SA(0, 1), a2 + hstepA, voffA);
            PG8_WAIT_V(8); PG8_WAIT_L(0); PG8_BAR; PG8_MMA(0, 0, At, B0); PG8_MMA(0, 1, At, B1); PG8_BAR; PG8_SCHED;
            PG8_LDA(At, 1, 1); PG8_STAGE(PG8_SB(1, 0), b3, voffB); PG8_STAGE(PG8_SB(1, 1), b3 + hstepB, voffB); PG8_STAGE(PG8_SA(1, 0), a3, voffA);
            PG8_WAIT_V(8); PG8_WAIT_L(0); PG8_BAR; PG8_MMA(1, 0, At, B0); PG8_MMA(1, 1, At, B1); PG8_BAR; PG8_SCHED;
        }
        if constexpr (ALIGN_EPI) { if (wr == 0) PG8_BAR; }
        { int ln; asm volatile("v_mbcnt_lo_u32_b32 %0, -1, 0\n\tv_mbcnt_hi_u32_b32 %0, -1, %0" : "=v"(ln)); E(acc, cur, wr, wc, ln & 15, ln >> 4); }
        if (!has_next) break;
#pragma unroll
        for (int a = 0; a < 2; ++a)
#pragma unroll
            for (int b = 0; b < 2; ++b)
#pragma unroll
                for (int m = 0; m < 4; ++m)
#pragma unroll
                    for (int n = 0; n < 2; ++n) acc[a][b][m][n] = (f32x4){0.f, 0.f, 0.f, 0.f};
        cur = nxt; cA = nA; cB = nB; ++ui;
        if constexpr (ALIGN_EPI) { if (wr == 1) PG8_BAR; }
    }
    PG8_WAIT_V(0);
    if constexpr (!ALIGN_EPI) { if (wr == 0) PG8_BAR; }
    PG8_BAR;
#undef PG8_SA
#undef PG8_SB
#undef PG8_STAGE
#undef PG8_LDA
#undef PG8_LDB
#undef PG8_MMA
#undef PG8_WAIT_V
#undef PG8_WAIT_L
#undef PG8_BAR
#undef PG8_SCHED
}
}

using pg8::bf16_t; using pg8::f32x4; using pg8::u32x4; using pg8::Unit; using pg8::cvt_pk_bf16;
typedef unsigned u32x2 __attribute__((ext_vector_type(2)));
typedef short s16x8 __attribute__((ext_vector_type(8)));
typedef float f32x16 __attribute__((ext_vector_type(16)));
#define LAS __attribute__((address_space(3)))

constexpr int D = 1024, SEQ = 2048, NB = 32, DEPTH = 4, DFF = 2816, INW = 6048;
constexpr int GSEQ = 16, MG = GSEQ * SEQ, NGRP = NB / GSEQ;
constexpr int VT_LD = MG + 128;
constexpr float EPS = 1e-6f;
constexpr float QSCALE = 0.10206207261596575f * 1.4426950408889634f;
constexpr size_t W_IN = 0, W_UQ = W_IN + (size_t)6144 * 1024, W_K = W_UQ + 768 * 256, W_V = W_K + 512 * 256, W_BA = W_V + 512 * 256,
                 W_BB = W_BA + 1024 * 512, W_BC = W_BB + 1024 * 256, W_BD = W_BC + 1024 * 256, W_OUT = W_BD + 1024 * 256,
                 W_GU = W_OUT + (size_t)1024 * 1024, W_DN = W_GU + (size_t)5632 * 1024, W_LAYER = W_DN + (size_t)1024 * 2816;
constexpr size_t MiB = 1u << 20;
constexpr size_t WS_W = 0, WS_ROPE = 144 * MiB, WS_SSQ = 145 * MiB, WS_XN = 148 * MiB, WS_PROJ = 212 * MiB, WS_GATES = 340 * MiB, WS_Q = 596 * MiB,
                 WS_KN = 644 * MiB, WS_VT = 676 * MiB, WS_KR = 709 * MiB, WS_AO = 711 * MiB, WS_PB = 743 * MiB, WS_SC = 759 * MiB, WS_CD = 775 * MiB,
                 WS_CTL = 791 * MiB, CTL_ZERO_BYTES = 65536, WS_END = 792 * MiB,
                 WS_MERGED = WS_PROJ, WS_Y = WS_Q, WS_H = WS_GATES, WS_SGUW = WS_ROPE + 512 * 1024;
static_assert((size_t)MG * 2048 * 2 <= WS_GATES - WS_PROJ && (size_t)MG * 4096 * 2 <= WS_Q - WS_GATES && (size_t)MG * 1024 * 2 <= WS_VT - WS_Q && (size_t)MG * DFF * 2 <= WS_Q - WS_GATES && (size_t)3 * MG * 16 <= WS_XN - WS_SSQ, "d_ws map");
static_assert((size_t)512 * VT_LD * 2 <= WS_KR - WS_VT, "V^T fits");
static_assert(W_LAYER * 2 * DEPTH <= WS_ROPE, "weights fit");
constexpr int LDS_BYTES = 132096;

__device__ __forceinline__ float bflo(unsigned u) { return __uint_as_float(u << 16); }
__device__ __forceinline__ float bfhi(unsigned u) { return __uint_as_float(u & 0xffff0000u); }
__device__ __forceinline__ float sigmoidf_(float x) { return __builtin_amdgcn_rcpf(1.f + __expf(-x)); }
__device__ __forceinline__ u32x4 pack8(const f32x4 a, const f32x4 b) { u32x4 w; w.x = cvt_pk_bf16(a[0], a[1]); w.y = cvt_pk_bf16(a[2], a[3]); w.z = cvt_pk_bf16(b[0], b[1]); w.w = cvt_pk_bf16(b[2], b[3]); return w; }
__device__ __forceinline__ void unpack8(const u32x4 w, f32x4& a, f32x4& b) { a = (f32x4){bflo(w.x), bfhi(w.x), bflo(w.y), bfhi(w.y)}; b = (f32x4){bflo(w.z), bfhi(w.z), bflo(w.w), bfhi(w.w)}; }
__device__ __forceinline__ float dot4(const f32x4 a) { return (a[0] * a[0] + a[1] * a[1]) + (a[2] * a[2] + a[3] * a[3]); }

__device__ __forceinline__ float shx(float v, int o, int lane) { return __int_as_float(__builtin_amdgcn_ds_bpermute((lane ^ o) << 2, __float_as_int(v))); }
#define EPI_ROWS for (int ai = 0; ai < 2; ++ai) _Pragma("unroll") for (int m = 0; m < 4; ++m)
#define EPI_ROW (u.pm * 256 + ai * 128 + wr * 64 + m * 16 + fr)
#define EPI_COL8(bj) (u.pn * 256 + (bj) * 128 + wc * 32 + 8 * fq)

struct EpiInproj {
    bf16_t* proj; bf16_t* gates; float* ssq;
    __device__ __forceinline__ void operator()(const f32x4 (&acc)[2][2][4][2], const Unit& u, int wr, int wc, int fr, int fq) const {
        if (u.pn < 8) {
            const int kind = (u.pn == 0) ? 0 : (u.pn == 1) ? 1 : (u.pn == 4) ? 2 : -1;
#pragma unroll
            EPI_ROWS { const int row = EPI_ROW; float s = 0.f;
#pragma unroll
                for (int bj = 0; bj < 2; ++bj) { const f32x4 v0 = acc[ai][bj][m][0], v1 = acc[ai][bj][m][1];
                    *(u32x4*)(proj + (size_t)row * 2048 + EPI_COL8(bj)) = pack8(v0, v1);
                    if (bj == 0 || u.pn != 1) s += dot4(v0) + dot4(v1); }
                if (kind >= 0) { const int ln = fq * 16 + fr; s += shx(s, 16, ln); s += shx(s, 32, ln); if (fq == 0) ssq[((size_t)kind * MG + row) * 4 + wc] = s; }
            }
        } else {
#pragma unroll
            EPI_ROWS { const int row = EPI_ROW;
#pragma unroll
                for (int bj = 0; bj < 2; ++bj) { f32x4 v0 = acc[ai][bj][m][0], v1 = acc[ai][bj][m][1];
#pragma unroll
                    for (int j = 0; j < 4; ++j) { v0[j] = sigmoidf_(v0[j]); v1[j] = sigmoidf_(v1[j]); }
                    *(u32x4*)(gates + (size_t)row * 4096 + (EPI_COL8(bj) - 2048)) = pack8(v0, v1); }
            }
        }
    }
};
__device__ __forceinline__ float rstd_from(const float* ssq, int kind, int row, float inv_n) {
    const f32x4 s = *(const f32x4*)(ssq + ((size_t)kind * MG + row) * 4);
    return rsqrtf(((s[0] + s[1]) + (s[2] + s[3])) * inv_n + EPS);
}
struct EpiUq {
    bf16_t* Q; const float* ssq; const float2* rope;
    __device__ __forceinline__ void operator()(const f32x4 (&acc)[2][2][4][2], const Unit& u, int wr, int wc, int fr, int fq) const {
#pragma unroll
        EPI_ROWS { const int row = EPI_ROW; const float rs = rstd_from(ssq, 0, row, 1.f / 256.f); const int pos = row & (SEQ - 1);
#pragma unroll
            for (int bj = 0; bj < 2; ++bj) { const int col8 = EPI_COL8(bj); const int w = col8 % 96;
                f32x4 v0 = acc[ai][bj][m][0] * rs, v1 = acc[ai][bj][m][1] * rs;
                if (w >= 64) { const float2* rp = rope + pos * 16 + ((w - 64) >> 1);
                    const float2 c0 = rp[0], c1 = rp[1], c2 = rp[2], c3 = rp[3];
                    f32x4 o0, o1;
                    o0[0] = v0[0] * c0.x - v0[1] * c0.y; o0[1] = v0[1] * c0.x + v0[0] * c0.y;
                    o0[2] = v0[2] * c1.x - v0[3] * c1.y; o0[3] = v0[3] * c1.x + v0[2] * c1.y;
                    o1[0] = v1[0] * c2.x - v1[1] * c2.y; o1[1] = v1[1] * c2.x + v1[0] * c2.y;
                    o1[2] = v1[2] * c3.x - v1[3] * c3.y; o1[3] = v1[3] * c3.x + v1[2] * c3.y;
                    v0 = o0; v1 = o1; }
                v0 = v0 * QSCALE; v1 = v1 * QSCALE;
                *(u32x4*)(Q + (size_t)row * 768 + col8) = pack8(v0, v1); }
        }
    }
};
struct EpiUk {
    bf16_t* KNF; const float* ssq;
    __device__ __forceinline__ void operator()(const f32x4 (&acc)[2][2][4][2], const Unit& u, int wr, int wc, int fr, int fq) const {
#pragma unroll
        EPI_ROWS { const int row = EPI_ROW; const float rs = rstd_from(ssq, 1, row, 1.f / 128.f);
            const int seq = row >> 11, t = row & 2047, kt = t >> 6, j = (t >> 5) & 1, r32 = t & 31;
#pragma unroll
            for (int bj = 0; bj < 2; ++bj) { const int col8 = EPI_COL8(bj); const int h = col8 >> 6, d0 = col8 & 63, ks = d0 >> 4, hi = (d0 >> 3) & 1;
                *(u32x4*)(KNF + ((size_t)((((seq * 8 + h) * 32 + kt) * 4 + ks) * 2 + j) * 64 + hi * 32 + r32) * 8) = pack8(acc[ai][bj][m][0] * rs, acc[ai][bj][m][1] * rs); } }
    }
};
struct EpiUv {
    bf16_t* VF; const float* ssq;
    __device__ __forceinline__ void operator()(const f32x4 (&acc)[2][2][4][2], const Unit& u, int wr, int wc, int fr, int fq) const {
#pragma unroll
        for (int bj = 0; bj < 2; ++bj) {
            const int tok = EPI_COL8(bj); const int seq = tok >> 11, t = tok & 2047, kt = t >> 6, j4 = (t >> 4) & 3, half = (t >> 3) & 1;
            float rs[8];
#pragma unroll
            for (int j = 0; j < 8; ++j) rs[j] = rstd_from(ssq, 1, tok + j, 1.f / 128.f);
#pragma unroll
            EPI_ROWS { const int row = EPI_ROW; const int h = row >> 6, dt = (row >> 5) & 1, r32 = row & 31;
                f32x4 v0 = acc[ai][bj][m][0], v1 = acc[ai][bj][m][1];
#pragma unroll
                for (int j = 0; j < 4; ++j) { v0[j] *= rs[j]; v1[j] *= rs[4 + j]; }
                bf16_t* fp = VF + ((size_t)((((seq * 8 + h) * 32 + kt) * 4 + j4) * 2 + dt) * 64 + r32) * 8 + half * 4;
                u32x2 w0, w1; w0.x = cvt_pk_bf16(v0[0], v0[1]); w0.y = cvt_pk_bf16(v0[2], v0[3]); w1.x = cvt_pk_bf16(v1[0], v1[1]); w1.y = cvt_pk_bf16(v1[2], v1[3]);
                *(u32x2*)fp = w0; *(u32x2*)(fp + 32 * 8) = w1; }
            asm volatile("" ::: "memory");
        }
    }
};
struct EpiGate {
    bf16_t* merged; const bf16_t* gates; int b;
    __device__ __forceinline__ void operator()(const f32x4 (&acc)[2][2][4][2], const Unit& u, int wr, int wc, int fr, int fq) const {
#pragma unroll
        EPI_ROWS { const int row = EPI_ROW;
#pragma unroll
            for (int bj = 0; bj < 2; ++bj) { const int col8 = EPI_COL8(bj);
                const u32x4 gw = *(const u32x4*)(gates + (size_t)row * 4096 + b * 1024 + col8); f32x4 g0, g1; unpack8(gw, g0, g1);
                f32x4 v0 = acc[ai][bj][m][0] * g0, v1 = acc[ai][bj][m][1] * g1;
                bf16_t* mp = merged + (size_t)row * 1024 + col8;
                if (b != 0) { const u32x4 pw = *(const u32x4*)mp; f32x4 p0, p1; unpack8(pw, p0, p1); v0 = v0 + p0; v1 = v1 + p1; }
                *(u32x4*)mp = pack8(v0, v1); } }
    }
};
struct EpiPlain {
    bf16_t* O; int ldc;
    __device__ __forceinline__ void operator()(const f32x4 (&acc)[2][2][4][2], const Unit& u, int wr, int wc, int fr, int fq) const {
#pragma unroll
        EPI_ROWS { const int row = EPI_ROW;
#pragma unroll
            for (int bj = 0; bj < 2; ++bj) *(u32x4*)(O + (size_t)row * ldc + EPI_COL8(bj)) = pack8(acc[ai][bj][m][0], acc[ai][bj][m][1]); }
    }
};
struct EpiSwiglu {
    bf16_t* H;
    __device__ __forceinline__ void operator()(const f32x4 (&acc)[2][2][4][2], const Unit& u, int wr, int wc, int fr, int fq) const {
#pragma unroll
        EPI_ROWS { const int row = EPI_ROW; const int col8 = u.pn * 128 + wc * 32 + 8 * fq;
            f32x4 g0 = acc[ai][0][m][0], g1 = acc[ai][0][m][1]; const f32x4 u0 = acc[ai][1][m][0], u1 = acc[ai][1][m][1];
#pragma unroll
            for (int j = 0; j < 4; ++j) { g0[j] = g0[j] * sigmoidf_(g0[j]) * u0[j]; g1[j] = g1[j] * sigmoidf_(g1[j]) * u1[j]; }
            *(u32x4*)(H + (size_t)row * DFF + col8) = pack8(g0, g1); }
    }
};

struct Args { const float* in[24]; float* out; unsigned char* ws; };

__device__ __forceinline__ float wave_sum(float v, int lane) {
#pragma unroll
    for (int o = 1; o < 64; o <<= 1) v += shx(v, o, lane);
    return v;
}

template <int KIND> __device__ __forceinline__ int map_col(int np) {
    if (KIND == 0) return np;
    if (KIND == 1) return (np < 416) ? np : (np < 512 ? -1 : np - 96);
    if (KIND == 2) { const int h = np / 96, w = np % 96; if (w < 64) return h * 96 + w; const int p = w - 64; return h * 96 + 64 + (p >> 1) + 16 * (p & 1); }
    if (KIND == 3) return (np >> 6) * 128 + (np & 63);
    if (KIND == 4) return (np >> 6) * 128 + 64 + (np & 63);
    return 0;
}
template <int KIND> __device__ __forceinline__ void conv_weight(const float* __restrict__ W, int Ks, int Ns, bf16_t* __restrict__ Wt, int Nd, int Kd, const float* __restrict__ kscale, int gtid, int nthr) {
    const int items = Nd * (Kd / 8);
    for (int it = gtid; it < items; it += nthr) {
        const int np = it % Nd, k0 = (it / Nd) * 8; const int n = map_col<KIND>(np);
        float v[8];
#pragma unroll
        for (int j = 0; j < 8; ++j) { const int k = k0 + j; float x = 0.f; if (n >= 0 && k < Ks) { x = W[(size_t)k * Ns + n]; if (kscale) x *= kscale[k]; } v[j] = x; }
        u32x4 w; w.x = cvt_pk_bf16(v[0], v[1]); w.y = cvt_pk_bf16(v[2], v[3]); w.z = cvt_pk_bf16(v[4], v[5]); w.w = cvt_pk_bf16(v[6], v[7]);
        *(u32x4*)(Wt + (size_t)np * Kd + k0) = w;
    }
}
__device__ __forceinline__ void conv_gu(const float* __restrict__ Wg, const float* __restrict__ Wu, bf16_t* __restrict__ Wt, int gtid, int nthr) {
    const int items = 5632 * 128;
    for (int it = gtid; it < items; it += nthr) {
        const int np = it % 5632, k0 = (it / 5632) * 8; const int tile = np >> 8, wi = np & 255;
        const float* W = (wi < 128) ? Wg : Wu; const int n = tile * 128 + (wi & 127);
        float v[8];
#pragma unroll
        for (int j = 0; j < 8; ++j) v[j] = W[(size_t)(k0 + j) * DFF + n];
        u32x4 w; w.x = cvt_pk_bf16(v[0], v[1]); w.y = cvt_pk_bf16(v[2], v[3]); w.z = cvt_pk_bf16(v[4], v[5]); w.w = cvt_pk_bf16(v[6], v[7]);
        *(u32x4*)(Wt + (size_t)np * 1024 + k0) = w;
    }
}
__device__ __forceinline__ void conv_pool(const float* __restrict__ pw, const float* __restrict__ sc, const float* __restrict__ wb, bf16_t* __restrict__ Wt, int gtid, int nthr) {
    const int items = 1024 * 32;
    for (int it = gtid; it < items; it += nthr) {
        const int d = it & 1023, k0 = (it >> 10) * 8, g = k0 >> 6, kl0 = k0 & 63;
        float a[8];
#pragma unroll
        for (int j = 0; j < 8; ++j) a[j] = 0.f;
        for (int c = 0; c < 64; ++c) { const float x = sc[g * 64 + c] * wb[(size_t)(g * 64 + c) * 1024 + d];
#pragma unroll
            for (int j = 0; j < 8; ++j) a[j] += pw[(g * 64 + kl0 + j) * 64 + c] * x; }
        u32x4 w; w.x = cvt_pk_bf16(a[0], a[1]); w.y = cvt_pk_bf16(a[2], a[3]); w.z = cvt_pk_bf16(a[4], a[5]); w.w = cvt_pk_bf16(a[6], a[7]);
        *(u32x4*)(Wt + (size_t)d * 256 + k0) = w;
    }
}

__device__ __forceinline__ void norm_row(const float* __restrict__ xr, const float* __restrict__ g, bf16_t* __restrict__ o, int lane) {
    f32x4 v[4]; float s = 0.f;
#pragma unroll
    for (int j = 0; j < 4; ++j) { v[j] = *(const f32x4*)(xr + 4 * lane + 256 * j); s += dot4(v[j]); }
    const float rs = rsqrtf(wave_sum(s, lane) * (1.f / D) + EPS);
#pragma unroll
    for (int j = 0; j < 4; ++j) { const f32x4 gg = *(const f32x4*)(g + 4 * lane + 256 * j); const f32x4 t = v[j] * rs * gg;
        u32x2 w; w.x = cvt_pk_bf16(t[0], t[1]); w.y = cvt_pk_bf16(t[2], t[3]); *(u32x2*)(o + 4 * lane + 256 * j) = w; }
}
__device__ __forceinline__ void resid_row(const float* __restrict__ xr, const bf16_t* __restrict__ yr, const float* __restrict__ g1, float* __restrict__ xo, const float* __restrict__ gn, bf16_t* __restrict__ xn, int lane) {
    f32x4 y[4]; float s = 0.f;
#pragma unroll
    for (int j = 0; j < 4; ++j) { const u32x2 w = *(const u32x2*)(yr + 4 * lane + 256 * j); y[j] = (f32x4){bflo(w.x), bfhi(w.x), bflo(w.y), bfhi(w.y)}; s += dot4(y[j]); }
    const float rs = rsqrtf(wave_sum(s, lane) * (1.f / D) + EPS);
    float s2 = 0.f;
#pragma unroll
    for (int j = 0; j < 4; ++j) { const f32x4 gg = *(const f32x4*)(g1 + 4 * lane + 256 * j); const f32x4 xv = *(const f32x4*)(xr + 4 * lane + 256 * j);
        y[j] = xv + y[j] * rs * gg; *(f32x4*)(xo + 4 * lane + 256 * j) = y[j]; s2 += dot4(y[j]); }
    if (gn) { const float r2 = rsqrtf(wave_sum(s2, lane) * (1.f / D) + EPS);
#pragma unroll
        for (int j = 0; j < 4; ++j) { const f32x4 gg = *(const f32x4*)(gn + 4 * lane + 256 * j); const f32x4 t = y[j] * r2 * gg;
            u32x2 w; w.x = cvt_pk_bf16(t[0], t[1]); w.y = cvt_pk_bf16(t[2], t[3]); *(u32x2*)(xn + 4 * lane + 256 * j) = w; } }
}

__device__ __forceinline__ void attn_unit64(const bf16_t* __restrict__ Q, const bf16_t* __restrict__ KN, const bf16_t* __restrict__ KR, const bf16_t* __restrict__ VT,
                                            bf16_t* __restrict__ AO, int b, int h, int qc, int lane, LAS unsigned char* qlds) {
    const int r32 = lane & 31, hi = lane >> 5;
    const int tok0 = b * SEQ, q0 = tok0 + qc * 64;
    LAS s16x8* qs = (LAS s16x8*)qlds + lane;
#pragma unroll
    for (int qt = 0; qt < 2; ++qt)
#pragma unroll
        for (int ks = 0; ks < 6; ++ks) qs[(qt * 6 + ks) * 64] = *(const s16x8*)(Q + (size_t)(q0 + qt * 32 + r32) * 768 + h * 96 + ks * 16 + hi * 8);
    f32x16 o[2][2];
#pragma unroll
    for (int qt = 0; qt < 2; ++qt)
#pragma unroll
        for (int dt = 0; dt < 2; ++dt) o[qt][dt] = (f32x16){};
    float mrun[2] = {-1e30f, -1e30f}, lrun[2] = {0.f, 0.f};
    const bf16_t* knp = KN + (size_t)(b * 8 + h) * (32 * 4 * 2 * 512) + lane * 8;
    const bf16_t* krp = KR + (size_t)b * (32 * 2 * 2 * 512) + lane * 8;
    const bf16_t* vtp = VT + (size_t)(b * 8 + h) * (32 * 4 * 2 * 512) + lane * 8;
    for (int kt = 0; kt <= qc; ++kt) {
        LAS s16x8* qsv = qs; asm volatile("" : "+v"(qsv));
        s16x8 kf[6][2];
#pragma unroll
        for (int ks = 0; ks < 6; ++ks)
#pragma unroll
            for (int j = 0; j < 2; ++j)
                kf[ks][j] = (ks < 4) ? *(const s16x8*)(knp + ((kt * 4 + ks) * 2 + j) * 512) : *(const s16x8*)(krp + ((kt * 2 + (ks - 4)) * 2 + j) * 512);
        f32x16 p[2][2];
#pragma unroll
        for (int qt = 0; qt < 2; ++qt)
#pragma unroll
            for (int j = 0; j < 2; ++j) p[qt][j] = (f32x16){};
#pragma unroll
        for (int ks = 0; ks < 6; ++ks)
#pragma unroll
            for (int qt = 0; qt < 2; ++qt)
#pragma unroll
                for (int j = 0; j < 2; ++j) p[qt][j] = __builtin_amdgcn_mfma_f32_32x32x16_bf16(kf[ks][j], qsv[(qt * 6 + ks) * 64], p[qt][j], 0, 0, 0);
        u32x4 vf[4][2];
#pragma unroll
        for (int j4 = 0; j4 < 4; ++j4)
#pragma unroll
            for (int dt = 0; dt < 2; ++dt) vf[j4][dt] = *(const u32x4*)(vtp + ((kt * 4 + j4) * 2 + dt) * 512);
#pragma unroll
        for (int qt = 0; qt < 2; ++qt) {
            float mx = fmaxf(p[qt][0][0], p[qt][1][0]);
#pragma unroll
            for (int r = 1; r < 16; ++r) mx = __builtin_fmaxf(__builtin_fmaxf(mx, p[qt][0][r]), p[qt][1][r]);
            mx = fmaxf(mx, shx(mx, 32, lane));
            const float mnew = fmaxf(mrun[qt], mx);
            if (__any(mnew > mrun[qt])) {
                const float alpha = __builtin_amdgcn_exp2f(mrun[qt] - mnew);
                mrun[qt] = mnew; lrun[qt] *= alpha;
#pragma unroll
                for (int r = 0; r < 16; ++r) { o[qt][0][r] *= alpha; o[qt][1][r] *= alpha; }
            }
            float ls0 = 0.f, ls1 = 0.f;
#pragma unroll
            for (int r = 0; r < 16; ++r) { p[qt][0][r] = __builtin_amdgcn_exp2f(p[qt][0][r] - mnew); p[qt][1][r] = __builtin_amdgcn_exp2f(p[qt][1][r] - mnew); ls0 += p[qt][0][r]; ls1 += p[qt][1][r]; }
            lrun[qt] += ls0 + ls1;
        }
#pragma unroll
        for (int j4 = 0; j4 < 4; ++j4) {
            const int r0 = (j4 & 1) * 8;
#pragma unroll
            for (int qt = 0; qt < 2; ++qt) {
                const f32x16& pp = p[qt][j4 >> 1];
                u32x4 pw; pw.x = cvt_pk_bf16(pp[r0 + 0], pp[r0 + 1]); pw.y = cvt_pk_bf16(pp[r0 + 2], pp[r0 + 3]); pw.z = cvt_pk_bf16(pp[r0 + 4], pp[r0 + 5]); pw.w = cvt_pk_bf16(pp[r0 + 6], pp[r0 + 7]);
                const s16x8 pb = __builtin_bit_cast(s16x8, pw);
#pragma unroll
                for (int dt = 0; dt < 2; ++dt) o[qt][dt] = __builtin_amdgcn_mfma_f32_32x32x16_bf16(__builtin_bit_cast(s16x8, vf[j4][dt]), pb, o[qt][dt], 0, 0, 0);
            }
        }
    }
#pragma unroll
    for (int qt = 0; qt < 2; ++qt) {
        const float lt = lrun[qt] + shx(lrun[qt], 32, lane);
        const float inv = 1.f / lt;
        bf16_t* op = AO + (size_t)(q0 + qt * 32 + r32) * 512 + h * 64 + 4 * hi;
#pragma unroll
        for (int dt = 0; dt < 2; ++dt)
#pragma unroll
            for (int gq = 0; gq < 4; ++gq) {
                u32x2 w; w.x = cvt_pk_bf16(o[qt][dt][4 * gq] * inv, o[qt][dt][4 * gq + 1] * inv); w.y = cvt_pk_bf16(o[qt][dt][4 * gq + 2] * inv, o[qt][dt][4 * gq + 3] * inv);
                *(u32x2*)(op + 32 * dt + 8 * gq) = w; }
    }
}

#define XB_TMO      128
#define XB_XCNT(j)  (256  + 64 * (j))
#define XB_XSUB(j)  (1280 + 64 * (j))
#define XB_XGEN(j)  (2304 + 64 * (j))
#define XB_TOP      3328
#define XB_TOPGEN   3392
#define XCD_BAR_WORDS 3456
#define XB_SPIN_CAP (1u << 22)
__device__ __forceinline__ unsigned xb_ld(unsigned* p)              { return __hip_atomic_load(p, __ATOMIC_RELAXED, __HIP_MEMORY_SCOPE_AGENT); }
__device__ __forceinline__ unsigned xb_add(unsigned* p, unsigned v) { return __hip_atomic_fetch_add(p, v, __ATOMIC_RELAXED, __HIP_MEMORY_SCOPE_AGENT); }
__device__ __forceinline__ unsigned xb_xcc_id() { return (unsigned)__builtin_amdgcn_s_getreg((3 << 11) | 20) & 0xFu; }
#define XB_SPIN(cond, bar) do { unsigned _sp = 0; while (cond) { __builtin_amdgcn_s_sleep(1); \
    if ((++_sp & 255u) == 0u) { if (xb_ld(&(bar)[XB_TMO])) break; if (_sp > XB_SPIN_CAP) { atomicAdd(&(bar)[XB_TMO], 1u); break; } } } } while (0)
struct XcdBarrier { unsigned* bar; unsigned x; volatile LAS unsigned* st; };
__device__ __forceinline__ XcdBarrier xcd_barrier_post(unsigned* bar, volatile LAS unsigned* st, bool leader) {
    XcdBarrier b; b.bar = bar; b.x = xb_xcc_id(); b.st = st;
    if (leader) (void)xb_add(&bar[XB_XCNT(b.x)], 1u);
    return b;
}
__device__ __forceinline__ void xcd_barrier_complete(unsigned* bar, unsigned x, unsigned& nloc, unsigned& nx) {
    const unsigned G = gridDim.x * gridDim.y * gridDim.z;
    unsigned sum, cnt, mine, sp = 0u;
    for (;;) {
        sum = 0u; cnt = 0u; mine = 0u;
#pragma unroll
        for (unsigned j = 0; j < 16; ++j) { const unsigned c = xb_ld(&bar[XB_XCNT(j)]); sum += c; cnt += (c > 0u) ? 1u : 0u; mine = (j == x) ? c : mine; }
        if (sum == G) break;
        __builtin_amdgcn_s_sleep(1);
        if ((++sp & 255u) == 0u) { if (xb_ld(&bar[XB_TMO])) break; if (sp > XB_SPIN_CAP) { atomicAdd(&bar[XB_TMO], 1u); break; } }
    }
    nloc = mine > 0u ? mine : 1u; nx = cnt > 0u ? cnt : 1u;
}
__device__ __forceinline__ void xcd_barrier(const XcdBarrier& b, bool leader) {
    asm volatile("s_waitcnt vmcnt(0)" ::: "memory");
    __syncthreads();
    if (leader) {
        unsigned* bar = b.bar;
        __builtin_amdgcn_s_waitcnt(0);
        unsigned nloc = b.st[0], nx = b.st[1];
        if (nloc == 0u) { xcd_barrier_complete(bar, b.x, nloc, nx); b.st[0] = nloc; b.st[1] = nx; }
        const unsigned old = xb_add(&bar[XB_XSUB(b.x)], 1u);
        const unsigned gen = old / nloc;
        if (old + 1u == (gen + 1u) * nloc) {
            __builtin_amdgcn_fence(__ATOMIC_RELEASE, "agent");
            asm volatile("s_waitcnt vmcnt(0)" ::: "memory");
            const unsigned og = xb_add(&bar[XB_TOP], 1u);
            const unsigned tg = og / nx;
            if (og + 1u == (tg + 1u) * nx) xb_add(&bar[XB_TOPGEN], 1u);
            else XB_SPIN(xb_ld(&bar[XB_TOPGEN]) == tg, bar);
            __builtin_amdgcn_fence(__ATOMIC_ACQUIRE, "agent");
            xb_add(&bar[XB_XGEN(b.x)], 1u);
            asm volatile("s_waitcnt vmcnt(0)" ::: "memory");
        } else {
            XB_SPIN(xb_ld(&bar[XB_XGEN(b.x)]) == gen, bar);
            __builtin_amdgcn_fence(__ATOMIC_ACQUIRE, "agent");
            asm volatile("s_waitcnt vmcnt(0)" ::: "memory");
        }
    }
    __syncthreads();
}

#ifndef PROBE_MASK
#define PROBE_MASK 0
#endif
#define REP(bit) _Pragma("unroll") for (int rep_ = 0; rep_ < (((PROBE_MASK) >> (bit)) & 1) + 1; ++rep_)
#define GSYNC() do { PHASE_BEGIN(); xcd_barrier(xbar, tid == 0); if ((PROBE_MASK) & 1) xcd_barrier(xbar, tid == 0); } while (0)
__global__ void __launch_bounds__(512, 2) mega_fwd(Args a) {
    extern __shared__ __attribute__((aligned(16))) unsigned char lds_raw[];
    LAS unsigned char* lds = (LAS unsigned char*)lds_raw;
    cg::grid_group grid = cg::this_grid();
    const int wave0 = __builtin_amdgcn_readfirstlane((int)threadIdx.x >> 6);
    int tid, lane, wave, gtid, gw, G, bx, vcu, nthr, NGW;
#define REFRESH_TID() do { asm volatile("v_mbcnt_lo_u32_b32 %0, -1, 0\n\tv_mbcnt_hi_u32_b32 %0, -1, %0" : "=v"(lane)); wave = wave0; tid = wave * 64 + lane; \
        G = gridDim.x; bx = blockIdx.x; asm volatile("" : "+s"(G), "+s"(bx)); vcu = (G % 8 == 0) ? (bx % 8) * (G / 8) + bx / 8 : bx; nthr = G * 512; NGW = G * 8; gtid = bx * 512 + tid; gw = vcu * 8 + wave; } while (0)
    REFRESH_TID();
    typedef const Args __attribute__((address_space(4))) KArgs;
    KArgs* kap;
    unsigned char* ws; const float* x_in; float* xout;
#define PHASE_BEGIN() do { REFRESH_TID(); kap = (KArgs*)__builtin_amdgcn_kernarg_segment_ptr(); asm volatile("" : "+s"(kap)); ws = kap->ws; x_in = kap->in[0]; xout = kap->out; } while (0)
#define KIN(k) (kap->in[k])
#define Wb ((bf16_t*)(ws + WS_W))
#define ROPE ((float2*)(ws + WS_ROPE))
#define SSQ ((float*)(ws + WS_SSQ))
#define XN ((bf16_t*)(ws + WS_XN))
#define PROJ ((bf16_t*)(ws + WS_PROJ))
#define GATES ((bf16_t*)(ws + WS_GATES))
#define Qb ((bf16_t*)(ws + WS_Q))
#define KN ((bf16_t*)(ws + WS_KN))
#define VT ((bf16_t*)(ws + WS_VT))
#define KR ((bf16_t*)(ws + WS_KR))
#define AO ((bf16_t*)(ws + WS_AO))
#define PB ((bf16_t*)(ws + WS_PB))
#define SC ((bf16_t*)(ws + WS_SC))
#define CD ((bf16_t*)(ws + WS_CD))
#define MERGED ((bf16_t*)(ws + WS_MERGED))
#define Yb ((bf16_t*)(ws + WS_Y))
#define Hb ((bf16_t*)(ws + WS_H))
    PHASE_BEGIN();
    if (tid < 2) ((volatile LAS unsigned*)(lds + 131072))[tid] = 0u;
    __syncthreads();
    const XcdBarrier xbar = xcd_barrier_post((unsigned*)(ws + WS_CTL), (volatile LAS unsigned*)(lds + 131072), tid == 0);
    {
    const float *w_in = KIN(1), *g_pre_mix = KIN(2), *g_cq = KIN(3), *g_ckv = KIN(4), *w_uq = KIN(5), *w_ukv = KIN(6), *pool_w = KIN(7), *pool_scale = KIN(8),
                *w_br_a = KIN(13), *w_br_b = KIN(14), *w_br_c = KIN(15), *w_br_d = KIN(16),
                *w_out = KIN(17), *w_ffn_gate = KIN(20), *w_ffn_up = KIN(21), *w_ffn_down = KIN(22);

    for (int l = 0; l < DEPTH; ++l) {
        bf16_t* Wp = Wb + (size_t)l * W_LAYER;
        conv_weight<1>(w_in + (size_t)l * D * INW, D, INW, Wp + W_IN, 6144, 1024, nullptr, gtid, nthr);
        conv_weight<2>(w_uq + (size_t)l * 256 * 768, 256, 768, Wp + W_UQ, 768, 256, g_cq + l * 256, gtid, nthr);
        conv_weight<3>(w_ukv + (size_t)l * 128 * 1024, 128, 1024, Wp + W_K, 512, 256, g_ckv + l * 128, gtid, nthr);
        conv_weight<4>(w_ukv + (size_t)l * 128 * 1024, 128, 1024, Wp + W_V, 512, 256, g_ckv + l * 128, gtid, nthr);
        conv_weight<0>(w_br_a + (size_t)l * 512 * 1024, 512, 1024, Wp + W_BA, 1024, 512, nullptr, gtid, nthr);
        conv_pool(pool_w + (size_t)l * 4 * 64 * 64, pool_scale + l * 256, w_br_b + (size_t)l * 256 * 1024, Wp + W_BB, gtid, nthr);
        conv_weight<0>(w_br_c + (size_t)l * 256 * 1024, 256, 1024, Wp + W_BC, 1024, 256, nullptr, gtid, nthr);
        conv_weight<0>(w_br_d + (size_t)l * 256 * 1024, 256, 1024, Wp + W_BD, 1024, 256, nullptr, gtid, nthr);
        conv_weight<0>(w_out + (size_t)l * D * D, D, D, Wp + W_OUT, 1024, 1024, nullptr, gtid, nthr);
        conv_gu(w_ffn_gate + (size_t)l * D * DFF, w_ffn_up + (size_t)l * D * DFF, Wp + W_GU, gtid, nthr);
        conv_weight<0>(w_ffn_down + (size_t)l * DFF * D, DFF, D, Wp + W_DN, 1024, DFF, nullptr, gtid, nthr);
    }
    { const float* sw = KIN(10); bf16_t* w16 = (bf16_t*)(ws + WS_SGUW);
      for (int it = gtid; it < DEPTH * 4 * 128 * 128 / 2; it += nthr) { const float2 v = *(const float2*)(sw + 2 * it); *(unsigned*)(w16 + 2 * it) = cvt_pk_bf16(v.x, v.y); } }
    for (int it = gtid; it < SEQ * 16; it += nthr) { const int pos = it >> 4, i = it & 15;
        const float inv = powf(10000.0f, -(float)(2 * i) / 32.0f); const float ang = (float)pos * inv; ROPE[it] = make_float2(cosf(ang), sinf(ang)); }
    for (int r = gw; r < MG; r += NGW) norm_row(x_in + (size_t)r * D, g_pre_mix, XN + (size_t)r * D, lane);
    }
    grid.sync();

    for (int grp = 0; grp < NGRP; ++grp) {
        const size_t rowbase = (size_t)grp * MG;
        for (int l = 0; l < DEPTH; ++l) {
#define Wl (Wb + (size_t)l * W_LAYER)
            REP(1) { PHASE_BEGIN();
            { pg8::Gemm g{XN, Wl + W_IN, MG, 6144, 1024, 1024, 1024}; pg8::StaticOrder S; S.init(MG, 6144, G, bx);
              EpiInproj E{PROJ, GATES, SSQ}; pg8::gemm_phase<EpiInproj, true>(lds, g, S, E, tid); } }
            GSYNC();
            REP(3) { PHASE_BEGIN();
            { pg8::Gemm g{PROJ, Wl + W_UQ, MG, 768, 256, 2048, 256}; pg8::StaticOrder S; S.init(MG, 768, G, bx);
              EpiUq E{Qb, SSQ, ROPE}; pg8::gemm_phase<EpiUq, true>(lds, g, S, E, tid); }
            REFRESH_TID();
            { pg8::Gemm g{PROJ + 256, Wl + W_K, MG, 512, 256, 2048, 256}; pg8::StaticOrder S; S.init(MG, 512, G, (bx + 64) % G);
              EpiUk E{KN, SSQ}; pg8::gemm_phase<EpiUk, true>(lds, g, S, E, tid); }
            REFRESH_TID();
            { pg8::Gemm g{Wl + W_V, PROJ + 256, 512, MG, 256, 256, 2048}; pg8::StaticOrder S; S.init(512, MG, G, (bx + 128) % G);
              EpiUv E{VT, SSQ}; pg8::gemm_phase<EpiUv, true>(lds, g, S, E, tid); }
            PHASE_BEGIN();
            {
                const float* cw = KIN(12) + (size_t)l * 3 * 256;
                for (int it = gtid; it < (MG / 16) * 68; it += nthr) {
                    const int rr = it / 68, c = it % 68, row0 = rr * 16, t0 = row0 & (SEQ - 1);
                    if (c < 32) {
                        const int w = 2 << (c >> 3); const int n0 = (t0 + 1 < w) ? (t0 + 1) : w;
                        const bf16_t* zp = PROJ + (size_t)row0 * 2048 + 512 + c * 8;
                        f32x4 s0 = {0.f, 0.f, 0.f, 0.f}, s1 = s0;
                        for (int k = 1; k < n0; ++k) { f32x4 a0, a1; unpack8(*(const u32x4*)(zp - (size_t)k * 2048), a0, a1); s0 = s0 + a0; s1 = s1 + a1; }
#pragma unroll 4
                        for (int i = 0; i < 16; ++i) { const int t = t0 + i;
                            f32x4 z0, z1; unpack8(*(const u32x4*)(zp + (size_t)i * 2048), z0, z1); s0 = s0 + z0; s1 = s1 + z1;
                            const int n = (t + 1 < w) ? (t + 1) : w; const float inv = 1.f / (float)n;
                            *(u32x4*)(PB + (size_t)(row0 + i) * 256 + c * 8) = pack8(s0 * inv - z0, s1 * inv - z1);
                            if (t + 1 - w >= 0) { f32x4 a0, a1; unpack8(*(const u32x4*)(zp + (ptrdiff_t)(i + 1 - w) * 2048), a0, a1); s0 = s0 - a0; s1 = s1 - a1; } }
                    } else if (c < 64) {
                        const int cc = (c - 32) * 8; const bf16_t* pr = PROJ + (size_t)row0 * 2048;
                        const f32x4 w0a = *(const f32x4*)(cw + cc), w0b = *(const f32x4*)(cw + cc + 4), w1a = *(const f32x4*)(cw + 256 + cc), w1b = *(const f32x4*)(cw + 256 + cc + 4),
                                    w2a = *(const f32x4*)(cw + 512 + cc), w2b = *(const f32x4*)(cw + 512 + cc + 4);
                        f32x4 m2a = {0.f, 0.f, 0.f, 0.f}, m2b = m2a, m1a = m2a, m1b = m2a;
                        if (t0 >= 2) { f32x4 c0, c1, x0, x1; unpack8(*(const u32x4*)(pr - 2 * 2048 + 1536 + cc), c0, c1); unpack8(*(const u32x4*)(pr - 2 * 2048 + 1792 + cc), x0, x1); m2a = c0 * x0; m2b = c1 * x1; }
                        if (t0 >= 1) { f32x4 c0, c1, x0, x1; unpack8(*(const u32x4*)(pr - 2048 + 1536 + cc), c0, c1); unpack8(*(const u32x4*)(pr - 2048 + 1792 + cc), x0, x1); m1a = c0 * x0; m1b = c1 * x1; }
#pragma unroll 4
                        for (int i = 0; i < 16; ++i) { const bf16_t* p = pr + (size_t)i * 2048;
                            f32x4 c0, c1, x0, x1, b0, b1; unpack8(*(const u32x4*)(p + 1536 + cc), c0, c1); unpack8(*(const u32x4*)(p + 1792 + cc), x0, x1); unpack8(*(const u32x4*)(p + 1280 + cc), b0, b1);
                            const f32x4 za = c0 * x0, zb = c1 * x1;
                            const f32x4 ya = w0a * m2a + w1a * m1a + w2a * za, yb = w0b * m2b + w1b * m1b + w2b * zb;
                            *(u32x4*)(CD + (size_t)(row0 + i) * 256 + cc) = pack8(b0 * ya, b1 * yb);
                            m2a = m1a; m2b = m1b; m1a = za; m1b = zb; }
                    } else {
                        const int j = c - 64;
#pragma unroll 4
                        for (int i = 0; i < 16; ++i) { const int row = row0 + i, t = t0 + i; const bf16_t* pr = PROJ + (size_t)row * 2048 + 384;
                            const u32x2 a = *(const u32x2*)(pr + 4 * j), b2 = *(const u32x2*)(pr + 16 + 4 * j);
                            const float x1[4] = {bflo(a.x), bfhi(a.x), bflo(a.y), bfhi(a.y)}, x2[4] = {bflo(b2.x), bfhi(b2.x), bflo(b2.y), bfhi(b2.y)};
                            f32x4 o0, o1;
#pragma unroll
                            for (int q = 0; q < 4; ++q) { const float2 cs = ROPE[t * 16 + 4 * j + q]; const float r1 = x1[q] * cs.x - x2[q] * cs.y, r2 = x2[q] * cs.x + x1[q] * cs.y;
                                if (q < 2) { o0[2 * q] = r1; o0[2 * q + 1] = r2; } else { o1[2 * (q - 2)] = r1; o1[2 * (q - 2) + 1] = r2; } }
                            const int seq = row >> 11, kt = t >> 6, jj = (t >> 5) & 1, r32 = t & 31;
                            *(u32x4*)(KR + ((size_t)(((seq * 32 + kt) * 2 + (j >> 1)) * 2 + jj) * 64 + (j & 1) * 32 + r32) * 8) = pack8(o0, o1); }
                    }
                }
            }
            PHASE_BEGIN();
            {
                LAS bf16_t* VnT = (LAS bf16_t*)lds;
                const bf16_t* W16 = (const bf16_t*)(ws + WS_SGUW) + (size_t)l * 65536; const float* sb = KIN(11) + (size_t)l * 4 * 128; const float* gv = KIN(9) + (size_t)l * 256;
                const int r32 = lane & 31, hi = lane >> 5, itile = wave >> 1, ct = wave & 1;
                for (int un = bx; un < (MG / 128) * 4; un += G) {
                    const int nb = un >> 2, g = un & 3; const int row0 = nb * 128;
                    __syncthreads();
                    for (int i = tid; i < 1024; i += 512) { const int j = i & 127, c8 = (i >> 7) * 8; const int row = row0 + j;
                        const float rs = rstd_from(SSQ, 2, row, 1.f / 256.f);
                        f32x4 v0, v1; unpack8(*(const u32x4*)(PROJ + (size_t)row * 2048 + 1024 + g * 64 + c8), v0, v1);
                        const f32x4 g0 = *(const f32x4*)(gv + g * 64 + c8), g1 = *(const f32x4*)(gv + g * 64 + c8 + 4);
                        v0 = v0 * rs * g0; v1 = v1 * rs * g1;
                        const unsigned p0 = cvt_pk_bf16(v0[0], v0[1]), p1 = cvt_pk_bf16(v0[2], v0[3]), p2 = cvt_pk_bf16(v1[0], v1[1]), p3 = cvt_pk_bf16(v1[2], v1[3]);
                        LAS bf16_t* d = VnT + c8 * 136 + j;
                        d[0] = (bf16_t)(p0 & 0xffffu); d[136] = (bf16_t)(p0 >> 16); d[2 * 136] = (bf16_t)(p1 & 0xffffu); d[3 * 136] = (bf16_t)(p1 >> 16);
                        d[4 * 136] = (bf16_t)(p2 & 0xffffu); d[5 * 136] = (bf16_t)(p2 >> 16); d[6 * 136] = (bf16_t)(p3 & 0xffffu); d[7 * 136] = (bf16_t)(p3 >> 16); }
                    __syncthreads();
                    f32x16 acc = {};
                    const bf16_t* wp = W16 + (size_t)g * 16384 + (32 * itile + r32) * 128 + hi * 8;
                    const LAS bf16_t* bp = VnT + (32 * ct + r32) * 136 + hi * 8;
#pragma unroll
                    for (int ks = 0; ks < 8; ++ks) if (ks < 4 || itile >= 2)
                        acc = __builtin_amdgcn_mfma_f32_32x32x16_bf16(*(const s16x8*)(wp + ks * 16), *(const LAS s16x8*)(bp + ks * 16), acc, 0, 0, 0);
                    const int c = 32 * ct + r32;
#pragma unroll
                    for (int r = 0; r < 16; ++r) { const int i = 32 * itile + (r & 3) + 8 * (r >> 2) + 4 * hi; const int row = row0 + i;
                        const float uu = bflo((unsigned)PROJ[(size_t)row * 2048 + 768 + g * 64 + c]);
                        const float o = uu * (acc[r] + sb[g * 128 + i]);
                        SC[(size_t)row * 256 + g * 64 + c] = (bf16_t)(cvt_pk_bf16(o, 0.f) & 0xffffu); }
                }
                __syncthreads();
            } }
            GSYNC();
            REP(2) { PHASE_BEGIN();
            for (int wu = gw; wu < GSEQ * 8 * 16; wu += NGW) {
                const int bh = wu >> 4, qc = wu & 15;
                attn_unit64(Qb, KN, KR, VT, AO, bh >> 3, bh & 7, qc, lane, lds + wave * 12288);
                attn_unit64(Qb, KN, KR, VT, AO, bh >> 3, bh & 7, 31 - qc, lane, lds + wave * 12288);
            } }
            GSYNC();
            REP(4) { PHASE_BEGIN();
            { pg8::StaticOrder S; S.init(MG, 1024, G, bx);
              { pg8::Gemm g{AO, Wl + W_BA, MG, 1024, 512, 512, 512}; EpiGate E{MERGED, GATES, 0}; pg8::gemm_phase<EpiGate, true>(lds, g, S, E, tid); }
              for (int b = 1; b < 4; ++b) { REFRESH_TID(); const bf16_t* Ab = (b == 1) ? PB : (b == 2) ? SC : CD; const bf16_t* Wbb = Wl + ((b == 1) ? W_BB : (b == 2) ? W_BC : W_BD);
                pg8::Gemm g{Ab, Wbb, MG, 1024, 256, 256, 256}; EpiGate E{MERGED, GATES, b}; pg8::gemm_phase<EpiGate, true>(lds, g, S, E, tid); } } }
            GSYNC();
            REP(1) { PHASE_BEGIN();
            { pg8::Gemm g{MERGED, Wl + W_OUT, MG, 1024, 1024, 1024, 1024}; pg8::StaticOrder S; S.init(MG, 1024, G, bx);
              EpiPlain E{Yb, 1024}; pg8::gemm_phase<EpiPlain, true>(lds, g, S, E, tid); } }
            GSYNC();
            PHASE_BEGIN();
            { const float* xs = (l == 0) ? x_in : xout;
              for (int r = gw; r < MG; r += NGW) resid_row(xs + (rowbase + r) * D, Yb + (size_t)r * D, KIN(18) + l * D, xout + (rowbase + r) * D, KIN(19) + l * D, XN + (size_t)r * D, lane); }
            GSYNC();
            REP(1) { PHASE_BEGIN();
            { pg8::Gemm g{XN, Wl + W_GU, MG, 5632, 1024, 1024, 1024}; pg8::StaticOrder S; S.init(MG, 5632, G, bx);
              EpiSwiglu E{Hb}; pg8::gemm_phase<EpiSwiglu, true>(lds, g, S, E, tid); } }
            GSYNC();
            REP(1) { PHASE_BEGIN();
            { pg8::Gemm g{Hb, Wl + W_DN, MG, 1024, DFF, DFF, DFF}; pg8::StaticOrder S; S.init(MG, 1024, G, bx);
              EpiPlain E{Yb, 1024}; pg8::gemm_phase<EpiPlain, true>(lds, g, S, E, tid); } }
            GSYNC();
            PHASE_BEGIN();
            { const float* gn = (l + 1 < DEPTH) ? KIN(2) + (l + 1) * D : nullptr;
              for (int r = gw; r < MG; r += NGW) resid_row(xout + (rowbase + r) * D, Yb + (size_t)r * D, KIN(23) + l * D, xout + (rowbase + r) * D, gn, XN + (size_t)r * D, lane);
              if (l + 1 == DEPTH && grp + 1 < NGRP) for (int r = gw; r < MG; r += NGW) norm_row(x_in + (rowbase + MG + r) * D, KIN(2), XN + (size_t)r * D, lane); }
            GSYNC();
        }
    }
}

extern "C" void kernel_launch(void* const* d_in, const int* in_sizes, int n_in, void* d_out, int out_size, void* d_ws, size_t ws_size, hipStream_t stream) {
    static int grid = 0;
    if (grid == 0) {
        if (n_in != 24 || ws_size < WS_END) { fprintf(stderr, "kernel_launch: unexpected inputs (n_in %d, ws %zu)\n", n_in, ws_size); grid = -1; return; }
        int dev = 0, cus = 0, per_cu = 0;
        hipGetDevice(&dev); hipDeviceGetAttribute(&cus, hipDeviceAttributeMultiprocessorCount, dev);
        hipFuncSetAttribute((const void*)mega_fwd, hipFuncAttributeMaxDynamicSharedMemorySize, LDS_BYTES);
        if (hipOccupancyMaxActiveBlocksPerMultiprocessor(&per_cu, (const void*)mega_fwd, 512, LDS_BYTES) != hipSuccess || per_cu < 1) { fprintf(stderr, "kernel_launch: occupancy query says %d\n", per_cu); per_cu = 1; }
        (void)hipGetLastError();
        grid = cus * 1;
    }
    if (grid < 0) return;
    if (hipMemsetAsync((char*)d_ws + WS_CTL, 0, CTL_ZERO_BYTES, stream) != hipSuccess) { fprintf(stderr, "kernel_launch: memset failed\n"); return; }
    Args a{};
    for (int i = 0; i < 24; ++i) a.in[i] = (const float*)d_in[i];
    a.out = (float*)d_out; a.ws = (unsigned char*)d_ws;
    void* args[] = {&a};
    hipError_t e = hipLaunchCooperativeKernel((const void*)mega_fwd, dim3(grid), dim3(512), args, LDS_BYTES, stream);
    if (e != hipSuccess) fprintf(stderr, "cooperative launch failed: %s (grid %d)\n", hipGetErrorString(e), grid);
}
```

```cpp
#include <hip/hip_runtime.h>
#include <hip/hip_cooperative_groups.h>
#include <cstdio>
#include <cstdint>
namespace cg = cooperative_groups;

namespace pg8 {
#define PG8_LAS __attribute__((address_space(3)))
typedef unsigned short bf16_t;
typedef short bf16x8 __attribute__((ext_vector_type(8)));
typedef float f32x4 __attribute__((ext_vector_type(4)));
typedef unsigned u32x4 __attribute__((ext_vector_type(4)));
constexpr int BM = 256, BK = 64, HALF = 128, HTB = HALF * BK * 2, STAGE_BYTES = 8 * HTB, NXCD = 8, WGM = 8;

__host__ __device__ __forceinline__ int lds_byte(int r, int c) { const int st = (r >> 4) * 2 + (c >> 5), rr = r & 15, cc = c & 31, ob = rr * 64 + cc * 2; return st * 1024 + (ob ^ (((ob >> 9) & 1) << 5)); }
__host__ __device__ __forceinline__ void stage_rc(int b, int& R, int& C) { const int st = b / 1024, sb = b % 1024, swz = sb ^ (((sb >> 9) & 1) << 5); R = (st >> 1) * 16 + swz / 64; C = (st & 1) * 32 + (swz % 64) / 2; }
__host__ __device__ __forceinline__ int perm32(int rho) { const int n = rho >> 4, i = rho & 15; return 8 * (i >> 2) + 4 * n + (i & 3); }

struct Unit { int pm, pn; };
struct Gemm { const bf16_t* A; const bf16_t* Bt; int M, N, K, lda, ldb; };

struct StaticOrder {
    int nM, nN, nwg, G, c;
    __host__ __device__ void init(int M, int N, int G_, int c_) { nM = M / BM; nN = N / BM; nwg = nM * nN; G = G_; c = c_; }
    __host__ __device__ bool next(int i, Unit& u) const {
        const long L = (long)i * G + c; if (L >= nwg) return false;
        int wgid = (int)L; { const int q = nwg / NXCD, r = nwg % NXCD, xcd = wgid % NXCD, off = wgid / NXCD; wgid = (xcd < r ? xcd * (q + 1) : r * (q + 1) + (xcd - r) * q) + off; }
        const int nig = WGM * nN, gid = wgid / nig, fm = gid * WGM, gsz = (nM - fm) < WGM ? (nM - fm) : WGM;
        u.pm = fm + ((wgid % nig) % gsz); u.pn = (wgid % nig) / gsz; return true;
    }
};

typedef float f32x2_t __attribute__((ext_vector_type(2))); typedef __bf16 bf16x2_t __attribute__((ext_vector_type(2)));
__device__ __forceinline__ unsigned cvt_pk_bf16(float lo, float hi) { f32x2_t v = {lo, hi}; bf16x2_t b = __builtin_convertvector(v, bf16x2_t); return __builtin_bit_cast(unsigned, b); }

template <class Epi, bool ALIGN_EPI>
__device__ __forceinline__ void gemm_phase(PG8_LAS unsigned char* lds, const Gemm g, const StaticOrder& S, const Epi& E, int tid) {
    const int wid = __builtin_amdgcn_readfirstlane(tid >> 6), lane = tid & 63, wr = wid >> 2, wc = wid & 3, fr = lane & 15, fq = lane >> 4;
    const int K = g.K, nt = K / BK;
    unsigned voffA[2], voffB[2];
#pragma unroll
    for (int i = 0; i < 2; ++i) { int R, C; stage_rc(tid * 16 + i * 8192, R, C); const int Rb = (R & ~31) + perm32(R & 31);
        voffA[i] = (unsigned)(R * g.lda + C) * 2u; voffB[i] = (unsigned)(Rb * g.ldb + C) * 2u; }
    const size_t kstep = (size_t)(BK * 2);
    const size_t hstepA = (size_t)HALF * g.lda * 2, hstepB = (size_t)HALF * g.ldb * 2;
    const size_t tstepA = 2 * hstepA, tstepB = 2 * hstepB;
    const unsigned ldsw = (unsigned)wid * 1024u;
    const int aoff = lds_byte(wr * 64 + fr, fq * 8), boff = lds_byte(wc * 32 + fr, fq * 8);
#define PG8_SA(b, h) (((b) * 2 + (h)) * HTB)
#define PG8_SB(b, h) ((4 + (b) * 2 + (h)) * HTB)
#define PG8_STAGE(bufoff, gbase, voff) do { _Pragma("unroll") for (int _i = 0; _i < 2; ++_i) \
        __builtin_amdgcn_global_load_lds((const unsigned*)((const char*)(gbase) + (voff)[_i]), (PG8_LAS unsigned*)(lds + (bufoff) + ldsw + _i * 8192), 16, 0, 0); } while (0)
#define PG8_LDA(dst, b, h) do { _Pragma("unroll") for (int m = 0; m < 4; ++m) _Pragma("unroll") for (int k = 0; k < 2; ++k) dst[m][k] = *(const PG8_LAS bf16x8*)(lds + PG8_SA(b, h) + aoff + m * 2048 + k * 1024); } while (0)
#define PG8_LDB(dst, b, h) do { _Pragma("unroll") for (int n = 0; n < 2; ++n) _Pragma("unroll") for (int k = 0; k < 2; ++k) dst[n][k] = *(const PG8_LAS bf16x8*)(lds + PG8_SB(b, h) + boff + n * 2048 + k * 1024); } while (0)
#define PG8_MMA(ai, bj, At, Bt) do { __builtin_amdgcn_s_setprio(1); _Pragma("unroll") for (int m = 0; m < 4; ++m) _Pragma("unroll") for (int n = 0; n < 2; ++n) _Pragma("unroll") for (int k = 0; k < 2; ++k) \
        acc[ai][bj][m][n] = __builtin_amdgcn_mfma_f32_16x16x32_bf16(Bt[n][k], At[m][k], acc[ai][bj][m][n], 0, 0, 0); __builtin_amdgcn_s_setprio(0); } while (0)
#define PG8_WAIT_V(n) asm volatile("s_waitcnt vmcnt(" #n ")" ::: "memory")
#define PG8_WAIT_L(n) asm volatile("s_waitcnt lgkmcnt(" #n ")" ::: "memory")
#define PG8_BAR __builtin_amdgcn_s_barrier()
#define PG8_SCHED __builtin_amdgcn_sched_barrier(0)
    Unit cur, nxt; int ui = 0;
    if (!S.next(0, cur)) return;
    f32x4 acc[2][2][4][2];
#pragma unroll
    for (int a = 0; a < 2; ++a)
#pragma unroll
        for (int b = 0; b < 2; ++b)
#pragma unroll
            for (int m = 0; m < 4; ++m)
#pragma unroll
                for (int n = 0; n < 2; ++n) acc[a][b][m][n] = (f32x4){0.f, 0.f, 0.f, 0.f};
    bf16x8 At[4][2], B0[2][2], B1[2][2];
    const char* cA = (const char*)g.A + (size_t)cur.pm * tstepA; const char* cB = (const char*)g.Bt + (size_t)cur.pn * tstepB;
    PG8_STAGE(PG8_SB(0, 0), cB, voffB); PG8_STAGE(PG8_SB(0, 1), cB + hstepB, voffB); PG8_STAGE(PG8_SA(0, 0), cA, voffA); PG8_STAGE(PG8_SA(0, 1), cA + hstepA, voffA);
    if (wr == 1) PG8_BAR;
    PG8_WAIT_V(2); PG8_BAR;
    PG8_STAGE(PG8_SB(1, 0), cB + kstep, voffB); PG8_STAGE(PG8_SA(1, 0), cA + kstep, voffA); PG8_STAGE(PG8_SB(1, 1), cB + hstepB + kstep, voffB);
    PG8_WAIT_V(6); PG8_BAR;
    for (;;) {
        const bool has_next = S.next(ui + 1, nxt);
        const char* nA = has_next ? (const char*)g.A + (size_t)nxt.pm * tstepA : cA; const char* nB = has_next ? (const char*)g.Bt + (size_t)nxt.pn * tstepB : cB;
        for (int t = 0; t < nt; t += 2) {
            const bool last = (t == nt - 2);
            const char* a1 = cA + (size_t)(t + 1) * kstep;
            const char* a2 = last ? nA : cA + (size_t)(t + 2) * kstep; const char* b2 = last ? nB : cB + (size_t)(t + 2) * kstep;
            const char* a3 = a2 + kstep; const char* b3 = b2 + kstep;
            PG8_LDB(B0, 0, 0); PG8_LDB(B1, 0, 1); PG8_SCHED; PG8_LDA(At, 0, 0); PG8_STAGE(PG8_SA(1, 1), a1 + hstepA, voffA);
            PG8_WAIT_V(8); PG8_WAIT_L(0); PG8_BAR; PG8_MMA(0, 0, At, B0); PG8_MMA(0, 1, At, B1); PG8_BAR; PG8_SCHED;
            PG8_LDA(At, 0, 1); PG8_STAGE(PG8_SB(0, 0), b2, voffB); PG8_STAGE(PG8_SB(0, 1), b2 + hstepB, voffB); PG8_STAGE(PG8_SA(0, 0), a2, voffA);
            PG8_WAIT_V(8); PG8_WAIT_L(0); PG8_BAR; PG8_MMA(1, 0, At, B0); PG8_MMA(1, 1, At, B1); PG8_BAR; PG8_SCHED;
            PG8_LDB(B0, 1, 0); PG8_LDB(B1, 1, 1); PG8_SCHED; PG8_LDA(At, 1, 0); PG8_STAGE(PG8_SA(0, 1), a2 + hstepA, voffA);
            PG8_WAIT_V(8); PG8_WAIT_L(0); PG8_BAR; PG8_MMA(0, 0, At, B0); PG8_MMA(0, 1, At, B1); PG8_BAR; PG8_SCHED;
            PG8_LDA(At, 1, 1); PG8_STAGE(PG8_SB(1, 0), b3, voffB); PG8_STAGE(PG8_SB(1, 1), b3 + hstepB, voffB); PG8_STAGE(PG8_SA(1, 0), a3, voffA);
            PG8_WAIT_V(8); PG8_WAIT_L(0); PG8_BAR; PG8_MMA(1, 0, At, B0); PG8_MMA(1, 1, At, B1); PG8_BAR; PG8_SCHED;
        }
        if constexpr (ALIGN_EPI) { if (wr == 0) PG8_BAR; }
        { int ln; asm volatile("v_mbcnt_lo_u32_b32 %0, -1, 0\n\tv_mbcnt_hi_u32_b32 %0, -1, %0" : "=v"(ln)); E(acc, cur, wr, wc, ln & 15, ln >> 4); }
        if (!has_next) break;
#pragma unroll
        for (int a = 0; a < 2; ++a)
#pragma unroll
            for (int b = 0; b < 2; ++b)
#pragma unroll
                for (int m = 0; m < 4; ++m)
#pragma unroll
                    for (int n = 0; n < 2; ++n) acc[a][b][m][n] = (f32x4){0.f, 0.f, 0.f, 0.f};
        cur = nxt; cA = nA; cB = nB; ++ui;
        if constexpr (ALIGN_EPI) { if (wr == 1) PG8_BAR; }
    }
    PG8_WAIT_V(0);
    if constexpr (!ALIGN_EPI) { if (wr == 0) PG8_BAR; }
    PG8_BAR;
#undef PG8_SA
#undef PG8_SB
#undef PG8_STAGE
#undef PG8_LDA
#undef PG8_LDB
#undef PG8_MMA
#undef PG8_WAIT_V
#undef PG8_WAIT_L
#undef PG8_BAR
#undef PG8_SCHED
}
}

using pg8::bf16_t; using pg8::f32x4; using pg8::u32x4; using pg8::Unit; using pg8::cvt_pk_bf16;
typedef unsigned u32x2 __attribute__((ext_vector_type(2)));
typedef short s16x8 __attribute__((ext_vector_type(8)));
typedef float f32x16 __attribute__((ext_vector_type(16)));
#define LAS __attribute__((address_space(3)))

constexpr int D = 1024, SEQ = 2048, NB = 32, DEPTH = 4, DFF = 2816, INW = 6048;
constexpr int GSEQ = 16, MG = GSEQ * SEQ, NGRP = NB / GSEQ;
constexpr int VT_LD = MG + 128;
constexpr float EPS = 1e-6f;
constexpr float QSCALE = 0.10206207261596575f * 1.4426950408889634f;
constexpr size_t W_IN = 0, W_UQ = W_IN + (size_t)6144 * 1024, W_K = W_UQ + 768 * 256, W_V = W_K + 512 * 256, W_BA = W_V + 512 * 256,
                 W_BB = W_BA + 1024 * 512, W_BC = W_BB + 1024 * 256, W_BD = W_BC + 1024 * 256, W_OUT = W_BD + 1024 * 256,
                 W_GU = W_OUT + (size_t)1024 * 1024, W_DN = W_GU + (size_t)5632 * 1024, W_LAYER = W_DN + (size_t)1024 * 2816;
constexpr size_t MiB = 1u << 20;
constexpr size_t WS_W = 0, WS_ROPE = 144 * MiB, WS_SSQ = 145 * MiB, WS_XN = 148 * MiB, WS_PROJ = 212 * MiB, WS_GATES = 340 * MiB, WS_Q = 596 * MiB,
                 WS_KN = 644 * MiB, WS_VT = 676 * MiB, WS_KR = 709 * MiB, WS_AO = 711 * MiB, WS_PB = 743 * MiB, WS_SC = 759 * MiB, WS_CD = 775 * MiB,
                 WS_CTL = 791 * MiB, CTL_ZERO_BYTES = 65536, WS_END = 792 * MiB,
                 WS_MERGED = WS_PROJ, WS_Y = WS_Q, WS_H = WS_GATES, WS_SGUW = WS_ROPE + 512 * 1024;
static_assert((size_t)MG * 2048 * 2 <= WS_GATES - WS_PROJ && (size_t)MG * 4096 * 2 <= WS_Q - WS_GATES && (size_t)MG * 1024 * 2 <= WS_VT - WS_Q && (size_t)MG * DFF * 2 <= WS_Q - WS_GATES && (size_t)3 * MG * 16 <= WS_XN - WS_SSQ, "d_ws map");
static_assert((size_t)512 * VT_LD * 2 <= WS_KR - WS_VT, "V^T fits");
static_assert(W_LAYER * 2 * DEPTH <= WS_ROPE, "weights fit");
constexpr int LDS_BYTES = 132096;

__device__ __forceinline__ float bflo(unsigned u) { return __uint_as_float(u << 16); }
__device__ __forceinline__ float bfhi(unsigned u) { return __uint_as_float(u & 0xffff0000u); }
__device__ __forceinline__ float sigmoidf_(float x) { return __builtin_amdgcn_rcpf(1.f + __expf(-x)); }
__device__ __forceinline__ u32x4 pack8(const f32x4 a, const f32x4 b) { u32x4 w; w.x = cvt_pk_bf16(a[0], a[1]); w.y = cvt_pk_bf16(a[2], a[3]); w.z = cvt_pk_bf16(b[0], b[1]); w.w = cvt_pk_bf16(b[2], b[3]); return w; }
__device__ __forceinline__ void unpack8(const u32x4 w, f32x4& a, f32x4& b) { a = (f32x4){bflo(w.x), bfhi(w.x), bflo(w.y), bfhi(w.y)}; b = (f32x4){bflo(w.z), bfhi(w.z), bflo(w.w), bfhi(w.w)}; }
__device__ __forceinline__ float dot4(const f32x4 a) { return (a[0] * a[0] + a[1] * a[1]) + (a[2] * a[2] + a[3] * a[3]); }

__device__ __forceinline__ float shx(float v, int o, int lane) { return __int_as_float(__builtin_amdgcn_ds_bpermute((lane ^ o) << 2, __float_as_int(v))); }
#define EPI_ROWS for (int ai = 0; ai < 2; ++ai) _Pragma("unroll") for (int m = 0; m < 4; ++m)
#define EPI_ROW (u.pm * 256 + ai * 128 + wr * 64 + m * 16 + fr)
#define EPI_COL8(bj) (u.pn * 256 + (bj) * 128 + wc * 32 + 8 * fq)

struct EpiInproj {
    bf16_t* proj; bf16_t* gates; float* ssq;
    __device__ __forceinline__ void operator()(const f32x4 (&acc)[2][2][4][2], const Unit& u, int wr, int wc, int fr, int fq) const {
        if (u.pn < 8) {
            const int kind = (u.pn == 0) ? 0 : (u.pn == 1) ? 1 : (u.pn == 4) ? 2 : -1;
#pragma unroll
            EPI_ROWS { const int row = EPI_ROW; float s = 0.f;
#pragma unroll
                for (int bj = 0; bj < 2; ++bj) { const f32x4 v0 = acc[ai][bj][m][0], v1 = acc[ai][bj][m][1];
                    *(u32x4*)(proj + (size_t)row * 2048 + EPI_COL8(bj)) = pack8(v0, v1);
                    if (bj == 0 || u.pn != 1) s += dot4(v0) + dot4(v1); }
                if (kind >= 0) { const int ln = fq * 16 + fr; s += shx(s, 16, ln); s += shx(s, 32, ln); if (fq == 0) ssq[((size_t)kind * MG + row) * 4 + wc] = s; }
            }
        } else {
#pragma unroll
            EPI_ROWS { const int row = EPI_ROW;
#pragma unroll
                for (int bj = 0; bj < 2; ++bj) { f32x4 v0 = acc[ai][bj][m][0], v1 = acc[ai][bj][m][1];
#pragma unroll
                    for (int j = 0; j < 4; ++j) { v0[j] = sigmoidf_(v0[j]); v1[j] = sigmoidf_(v1[j]); }
                    *(u32x4*)(gates + (size_t)row * 4096 + (EPI_COL8(bj) - 2048)) = pack8(v0, v1); }
            }
        }
    }
};
__device__ __forceinline__ float rstd_from(const float* ssq, int kind, int row, float inv_n) {
    const f32x4 s = *(const f32x4*)(ssq + ((size_t)kind * MG + row) * 4);
    return rsqrtf(((s[0] + s[1]) + (s[2] + s[3])) * inv_n + EPS);
}
struct EpiUq {
    bf16_t* Q; const float* ssq; const float2* rope;
    __device__ __forceinline__ void operator()(const f32x4 (&acc)[2][2][4][2], const Unit& u, int wr, int wc, int fr, int fq) const {
#pragma unroll
        EPI_ROWS { const int row = EPI_ROW; const float rs = rstd_from(ssq, 0, row, 1.f / 256.f); const int pos = row & (SEQ - 1);
#pragma unroll
            for (int bj = 0; bj < 2; ++bj) { const int col8 = EPI_COL8(bj); const int w = col8 % 96;
                f32x4 v0 = acc[ai][bj][m][0] * rs, v1 = acc[ai][bj][m][1] * rs;
                if (w >= 64) { const float2* rp = rope + pos * 16 + ((w - 64) >> 1);
                    const float2 c0 = rp[0], c1 = rp[1], c2 = rp[2], c3 = rp[3];
                    f32x4 o0, o1;
                    o0[0] = v0[0] * c0.x - v0[1] * c0.y; o0[1] = v0[1] * c0.x + v0[0] * c0.y;
                    o0[2] = v0[2] * c1.x - v0[3] * c1.y; o0[3] = v0[3] * c1.x + v0[2] * c1.y;
                    o1[0] = v1[0] * c2.x - v1[1] * c2.y; o1[1] = v1[1] * c2.x + v1[0] * c2.y;
                    o1[2] = v1[2] * c3.x - v1[3] * c3.y; o1[3] = v1[3] * c3.x + v1[2] * c3.y;
                    v0 = o0; v1 = o1; }
                v0 = v0 * QSCALE; v1 = v1 * QSCALE;
                *(u32x4*)(Q + (size_t)row * 768 + col8) = pack8(v0, v1); }
        }
    }
};
struct EpiUk {
    bf16_t* KNF; const float* ssq;
    __device__ __forceinline__ void operator()(const f32x4 (&acc)[2][2][4][2], const Unit& u, int wr, int wc, int fr, int fq) const {
#pragma unroll
        EPI_ROWS { const int row = EPI_ROW; const float rs = rstd_from(ssq, 1, row, 1.f / 128.f);
            const int seq = row >> 11, t = row & 2047, kt = t >> 6, j = (t >> 5) & 1, r32 = t & 31;
#pragma unroll
            for (int bj = 0; bj < 2; ++bj) { const int col8 = EPI_COL8(bj); const int h = col8 >> 6, d0 = col8 & 63, ks = d0 >> 4, hi = (d0 >> 3) & 1;
                *(u32x4*)(KNF + ((size_t)((((seq * 8 + h) * 32 + kt) * 4 + ks) * 2 + j) * 64 + hi * 32 + r32) * 8) = pack8(acc[ai][bj][m][0] * rs, acc[ai][bj][m][1] * rs); } }
    }
};
struct EpiUv {
    bf16_t* VF; const float* ssq;
    __device__ __forceinline__ void operator()(const f32x4 (&acc)[2][2][4][2], const Unit& u, int wr, int wc, int fr, int fq) const {
#pragma unroll
        for (int bj = 0; bj < 2; ++bj) {
            const int tok = EPI_COL8(bj); const int seq = tok >> 11, t = tok & 2047, kt = t >> 6, j4 = (t >> 4) & 3, half = (t >> 3) & 1;
            float rs[8];
#pragma unroll
            for (int j = 0; j < 8; ++j) rs[j] = rstd_from(ssq, 1, tok + j, 1.f / 128.f);
#pragma unroll
            EPI_ROWS { const int row = EPI_ROW; const int h = row >> 6, dt = (row >> 5) & 1, r32 = row & 31;
                f32x4 v0 = acc[ai][bj][m][0], v1 = acc[ai][bj][m][1];
#pragma unroll
                for (int j = 0; j < 4; ++j) { v0[j] *= rs[j]; v1[j] *= rs[4 + j]; }
                bf16_t* fp = VF + ((size_t)((((seq * 8 + h) * 32 + kt) * 4 + j4) * 2 + dt) * 64 + r32) * 8 + half * 4;
                u32x2 w0, w1; w0.x = cvt_pk_bf16(v0[0], v0[1]); w0.y = cvt_pk_bf16(v0[2], v0[3]); w1.x = cvt_pk_bf16(v1[0], v1[1]); w1.y = cvt_pk_bf16(v1[2], v1[3]);
                *(u32x2*)fp = w0; *(u32x2*)(fp + 32 * 8) = w1; }
            asm volatile("" ::: "memory");
        }
    }
};
struct EpiGate {
    bf16_t* merged; const bf16_t* gates; int b;
    __device__ __forceinline__ void operator()(const f32x4 (&acc)[2][2][4][2], const Unit& u, int wr, int wc, int fr, int fq) const {
#pragma unroll
        EPI_ROWS { const int row = EPI_ROW;
#pragma unroll
            for (int bj = 0; bj < 2; ++bj) { const int col8 = EPI_COL8(bj);
                const u32x4 gw = *(const u32x4*)(gates + (size_t)row * 4096 + b * 1024 + col8); f32x4 g0, g1; unpack8(gw, g0, g1);
                f32x4 v0 = acc[ai][bj][m][0] * g0, v1 = acc[ai][bj][m][1] * g1;
                bf16_t* mp = merged + (size_t)row * 1024 + col8;
                if (b != 0) { const u32x4 pw = *(const u32x4*)mp; f32x4 p0, p1; unpack8(pw, p0, p1); v0 = v0 + p0; v1 = v1 + p1; }
                *(u32x4*)mp = pack8(v0, v1); } }
    }
};
struct EpiPlain {
    bf16_t* O; int ldc;
    __device__ __forceinline__ void operator()(const f32x4 (&acc)[2][2][4][2], const Unit& u, int wr, int wc, int fr, int fq) const {
#pragma unroll
        EPI_ROWS { const int row = EPI_ROW;
#pragma unroll
            for (int bj = 0; bj < 2; ++bj) *(u32x4*)(O + (size_t)row * ldc + EPI_COL8(bj)) = pack8(acc[ai][bj][m][0], acc[ai][bj][m][1]); }
    }
};
struct EpiSwiglu {
    bf16_t* H;
    __device__ __forceinline__ void operator()(const f32x4 (&acc)[2][2][4][2], const Unit& u, int wr, int wc, int fr, int fq) const {
#pragma unroll
        EPI_ROWS { const int row = EPI_ROW; const int col8 = u.pn * 128 + wc * 32 + 8 * fq;
            f32x4 g0 = acc[ai][0][m][0], g1 = acc[ai][0][m][1]; const f32x4 u0 = acc[ai][1][m][0], u1 = acc[ai][1][m][1];
#pragma unroll
            for (int j = 0; j < 4; ++j) { g0[j] = g0[j] * sigmoidf_(g0[j]) * u0[j]; g1[j] = g1[j] * sigmoidf_(g1[j]) * u1[j]; }
            *(u32x4*)(H + (size_t)row * DFF + col8) = pack8(g0, g1); }
    }
};

struct Args { const float* in[24]; float* out; unsigned char* ws; };

__device__ __forceinline__ float wave_sum(float v, int lane) {
#pragma unroll
    for (int o = 1; o < 64; o <<= 1) v += shx(v, o, lane);
    return v;
}

template <int KIND> __device__ __forceinline__ int map_col(int np) {
    if (KIND == 0) return np;
    if (KIND == 1) return (np < 416) ? np : (np < 512 ? -1 : np - 96);
    if (KIND == 2) { const int h = np / 96, w = np % 96; if (w < 64) return h * 96 + w; const int p = w - 64; return h * 96 + 64 + (p >> 1) + 16 * (p & 1); }
    if (KIND == 3) return (np >> 6) * 128 + (np & 63);
    if (KIND == 4) return (np >> 6) * 128 + 64 + (np & 63);
    return 0;
}
template <int KIND> __device__ __forceinline__ void conv_weight(const float* __restrict__ W, int Ks, int Ns, bf16_t* __restrict__ Wt, int Nd, int Kd, const float* __restrict__ kscale, int gtid, int nthr) {
    const int items = Nd * (Kd / 8);
    for (int it = gtid; it < items; it += nthr) {
        const int np = it % Nd, k0 = (it / Nd) * 8; const int n = map_col<KIND>(np);
        float v[8];
#pragma unroll
        for (int j = 0; j < 8; ++j) { const int k = k0 + j; float x = 0.f; if (n >= 0 && k < Ks) { x = W[(size_t)k * Ns + n]; if (kscale) x *= kscale[k]; } v[j] = x; }
        u32x4 w; w.x = cvt_pk_bf16(v[0], v[1]); w.y = cvt_pk_bf16(v[2], v[3]); w.z = cvt_pk_bf16(v[4], v[5]); w.w = cvt_pk_bf16(v[6], v[7]);
        *(u32x4*)(Wt + (size_t)np * Kd + k0) = w;
    }
}
__device__ __forceinline__ void conv_gu(const float* __restrict__ Wg, const float* __restrict__ Wu, bf16_t* __restrict__ Wt, int gtid, int nthr) {
    const int items = 5632 * 128;
    for (int it = gtid; it < items; it += nthr) {
        const int np = it % 5632, k0 = (it / 5632) * 8; const int tile = np >> 8, wi = np & 255;
        const float* W = (wi < 128) ? Wg : Wu; const int n = tile * 128 + (wi & 127);
        float v[8];
#pragma unroll
        for (int j = 0; j < 8; ++j) v[j] = W[(size_t)(k0 + j) * DFF + n];
        u32x4 w; w.x = cvt_pk_bf16(v[0], v[1]); w.y = cvt_pk_bf16(v[2], v[3]); w.z = cvt_pk_bf16(v[4], v[5]); w.w = cvt_pk_bf16(v[6], v[7]);
        *(u32x4*)(Wt + (size_t)np * 1024 + k0) = w;
    }
}
__device__ __forceinline__ void conv_pool(const float* __restrict__ pw, const float* __restrict__ sc, const float* __restrict__ wb, bf16_t* __restrict__ Wt, int gtid, int nthr) {
    const int items = 1024 * 32;
    for (int it = gtid; it < items; it += nthr) {
        const int d = it & 1023, k0 = (it >> 10) * 8, g = k0 >> 6, kl0 = k0 & 63;
        float a[8];
#pragma unroll
        for (int j = 0; j < 8; ++j) a[j] = 0.f;
        for (int c = 0; c < 64; ++c) { const float x = sc[g * 64 + c] * wb[(size_t)(g * 64 + c) * 1024 + d];
#pragma unroll
            for (int j = 0; j < 8; ++j) a[j] += pw[(g * 64 + kl0 + j) * 64 + c] * x; }
        u32x4 w; w.x = cvt_pk_bf16(a[0], a[1]); w.y = cvt_pk_bf16(a[2], a[3]); w.z = cvt_pk_bf16(a[4], a[5]); w.w = cvt_pk_bf16(a[6], a[7]);
        *(u32x4*)(Wt + (size_t)d * 256 + k0) = w;
    }
}

__device__ __forceinline__ void norm_row(const float* __restrict__ xr, const float* __restrict__ g, bf16_t* __restrict__ o, int lane) {
    f32x4 v[4]; float s = 0.f;
#pragma unroll
    for (int j = 0; j < 4; ++j) { v[j] = *(const f32x4*)(xr + 4 * lane + 256 * j); s += dot4(v[j]); }
    const float rs = rsqrtf(wave_sum(s, lane) * (1.f / D) + EPS);
#pragma unroll
    for (int j = 0; j < 4; ++j) { const f32x4 gg = *(const f32x4*)(g + 4 * lane + 256 * j); const f32x4 t = v[j] * rs * gg;
        u32x2 w; w.x = cvt_pk_bf16(t[0], t[1]); w.y = cvt_pk_bf16(t[2], t[3]); *(u32x2*)(o + 4 * lane + 256 * j) = w; }
}
__device__ __forceinline__ void resid_row(const float* __restrict__ xr, const bf16_t* __restrict__ yr, const float* __restrict__ g1, float* __restrict__ xo, const float* __restrict__ gn, bf16_t* __restrict__ xn, int lane) {
    f32x4 y[4]; float s = 0.f;
#pragma unroll
    for (int j = 0; j < 4; ++j) { const u32x2 w = *(const u32x2*)(yr + 4 * lane + 256 * j); y[j] = (f32x4){bflo(w.x), bfhi(w.x), bflo(w.y), bfhi(w.y)}; s += dot4(y[j]); }
    const float rs = rsqrtf(wave_sum(s, lane) * (1.f / D) + EPS);
    float s2 = 0.f;
#pragma unroll
    for (int j = 0; j < 4; ++j) { const f32x4 gg = *(const f32x4*)(g1 + 4 * lane + 256 * j); const f32x4 xv = *(const f32x4*)(xr + 4 * lane + 256 * j);
        y[j] = xv + y[j] * rs * gg; *(f32x4*)(xo + 4 * lane + 256 * j) = y[j]; s2 += dot4(y[j]); }
    if (gn) { const float r2 = rsqrtf(wave_sum(s2, lane) * (1.f / D) + EPS);
#pragma unroll
        for (int j = 0; j < 4; ++j) { const f32x4 gg = *(const f32x4*)(gn + 4 * lane + 256 * j); const f32x4 t = y[j] * r2 * gg;
            u32x2 w; w.x = cvt_pk_bf16(t[0], t[1]); w.y = cvt_pk_bf16(t[2], t[3]); *(u32x2*)(xn + 4 * lane + 256 * j) = w; } }
}

__device__ __forceinline__ void attn_unit64(const bf16_t* __restrict__ Q, const bf16_t* __restrict__ KN, const bf16_t* __restrict__ KR, const bf16_t* __restrict__ VT,
                                            bf16_t* __restrict__ AO, int b, int h, int qc, int lane, LAS unsigned char* qlds) {
    const int r32 = lane & 31, hi = lane >> 5;
    const int tok0 = b * SEQ, q0 = tok0 + qc * 64;
    LAS s16x8* qs = (LAS s16x8*)qlds + lane;
#pragma unroll
    for (int qt = 0; qt < 2; ++qt)
#pragma unroll
        for (int ks = 0; ks < 6; ++ks) qs[(qt * 6 + ks) * 64] = *(const s16x8*)(Q + (size_t)(q0 + qt * 32 + r32) * 768 + h * 96 + ks * 16 + hi * 8);
    f32x16 o[2][2];
#pragma unroll
    for (int qt = 0; qt < 2; ++qt)
#pragma unroll
        for (int dt = 0; dt < 2; ++dt) o[qt][dt] = (f32x16){};
    float mrun[2] = {-1e30f, -1e30f}, lrun[2] = {0.f, 0.f};
    const bf16_t* knp = KN + (size_t)(b * 8 + h) * (32 * 4 * 2 * 512) + lane * 8;
    const bf16_t* krp = KR + (size_t)b * (32 * 2 * 2 * 512) + lane * 8;
    const bf16_t* vtp = VT + (size_t)(b * 8 + h) * (32 * 4 * 2 * 512) + lane * 8;
    for (int kt = 0; kt <= qc; ++kt) {
        LAS s16x8* qsv = qs; asm volatile("" : "+v"(qsv));
        s16x8 kf[6][2];
#pragma unroll
        for (int ks = 0; ks < 6; ++ks)
#pragma unroll
            for (int j = 0; j < 2; ++j)
                kf[ks][j] = (ks < 4) ? *(const s16x8*)(knp + ((kt * 4 + ks) * 2 + j) * 512) : *(const s16x8*)(krp + ((kt * 2 + (ks - 4)) * 2 + j) * 512);
        f32x16 p[2][2];
#pragma unroll
        for (int qt = 0; qt < 2; ++qt)
#pragma unroll
            for (int j = 0; j < 2; ++j) p[qt][j] = (f32x16){};
#pragma unroll
        for (int ks = 0; ks < 6; ++ks)
#pragma unroll
            for (int qt = 0; qt < 2; ++qt)
#pragma unroll
                for (int j = 0; j < 2; ++j) p[qt][j] = __builtin_amdgcn_mfma_f32_32x32x16_bf16(kf[ks][j], qsv[(qt * 6 + ks) * 64], p[qt][j], 0, 0, 0);
        u32x4 vf[4][2];
#pragma unroll
        for (int j4 = 0; j4 < 4; ++j4)
#pragma unroll
            for (int dt = 0; dt < 2; ++dt) vf[j4][dt] = *(const u32x4*)(vtp + ((kt * 4 + j4) * 2 + dt) * 512);
#pragma unroll
        for (int qt = 0; qt < 2; ++qt) {
            float mx = fmaxf(p[qt][0][0], p[qt][1][0]);
#pragma unroll
            for (int r = 1; r < 16; ++r) mx = __builtin_fmaxf(__builtin_fmaxf(mx, p[qt][0][r]), p[qt][1][r]);
            mx = fmaxf(mx, shx(mx, 32, lane));
            const float mnew = fmaxf(mrun[qt], mx);
            if (__any(mnew > mrun[qt])) {
                const float alpha = __builtin_amdgcn_exp2f(mrun[qt] - mnew);
                mrun[qt] = mnew; lrun[qt] *= alpha;
#pragma unroll
                for (int r = 0; r < 16; ++r) { o[qt][0][r] *= alpha; o[qt][1][r] *= alpha; }
            }
            float ls0 = 0.f, ls1 = 0.f;
#pragma unroll
            for (int r = 0; r < 16; ++r) { p[qt][0][r] = __builtin_amdgcn_exp2f(p[qt][0][r] - mnew); p[qt][1][r] = __builtin_amdgcn_exp2f(p[qt][1][r] - mnew); ls0 += p[qt][0][r]; ls1 += p[qt][1][r]; }
            lrun[qt] += ls0 + ls1;
        }
#pragma unroll
        for (int j4 = 0; j4 < 4; ++j4) {
            const int r0 = (j4 & 1) * 8;
#pragma unroll
            for (int qt = 0; qt < 2; ++qt) {
                const f32x16& pp = p[qt][j4 >> 1];
                u32x4 pw; pw.x = cvt_pk_bf16(pp[r0 + 0], pp[r0 + 1]); pw.y = cvt_pk_bf16(pp[r0 + 2], pp[r0 + 3]); pw.z = cvt_pk_bf16(pp[r0 + 4], pp[r0 + 5]); pw.w = cvt_pk_bf16(pp[r0 + 6], pp[r0 + 7]);
                const s16x8 pb = __builtin_bit_cast(s16x8, pw);
#pragma unroll
                for (int dt = 0; dt < 2; ++dt) o[qt][dt] = __builtin_amdgcn_mfma_f32_32x32x16_bf16(__builtin_bit_cast(s16x8, vf[j4][dt]), pb, o[qt][dt], 0, 0, 0);
            }
        }
    }
#pragma unroll
    for (int qt = 0; qt < 2; ++qt) {
        const float lt = lrun[qt] + shx(lrun[qt], 32, lane);
        const float inv = 1.f / lt;
        bf16_t* op = AO + (size_t)(q0 + qt * 32 + r32) * 512 + h * 64 + 4 * hi;
#pragma unroll
        for (int dt = 0; dt < 2; ++dt)
#pragma unroll
            for (int gq = 0; gq < 4; ++gq) {
                u32x2 w; w.x = cvt_pk_bf16(o[qt][dt][4 * gq] * inv, o[qt][dt][4 * gq + 1] * inv); w.y = cvt_pk_bf16(o[qt][dt][4 * gq + 2] * inv, o[qt][dt][4 * gq + 3] * inv);
                *(u32x2*)(op + 32 * dt + 8 * gq) = w; }
    }
}

#define XB_TMO      128
#define XB_XCNT(j)  (256  + 64 * (j))
#define XB_XSUB(j)  (1280 + 64 * (j))
#define XB_XGEN(j)  (2304 + 64 * (j))
#define XB_TOP      3328
#define XB_TOPGEN   3392
#define XCD_BAR_WORDS 3456
#define XB_SPIN_CAP (1u << 22)
__device__ __forceinline__ unsigned xb_ld(unsigned* p)              { return __hip_atomic_load(p, __ATOMIC_RELAXED, __HIP_MEMORY_SCOPE_AGENT); }
__device__ __forceinline__ unsigned xb_add(unsigned* p, unsigned v) { return __hip_atomic_fetch_add(p, v, __ATOMIC_RELAXED, __HIP_MEMORY_SCOPE_AGENT); }
__device__ __forceinline__ unsigned xb_xcc_id() { return (unsigned)__builtin_amdgcn_s_getreg((3 << 11) | 20) & 0xFu; }
#define XB_SPIN(cond, bar) do { unsigned _sp = 0; while (cond) { __builtin_amdgcn_s_sleep(1); \
    if ((++_sp & 255u) == 0u) { if (xb_ld(&(bar)[XB_TMO])) break; if (_sp > XB_SPIN_CAP) { atomicAdd(&(bar)[XB_TMO], 1u); break; } } } } while (0)
struct XcdBarrier { unsigned* bar; unsigned x; volatile LAS unsigned* st; };
__device__ __forceinline__ XcdBarrier xcd_barrier_post(unsigned* bar, volatile LAS unsigned* st, bool leader) {
    XcdBarrier b; b.bar = bar; b.x = xb_xcc_id(); b.st = st;
    if (leader) (void)xb_add(&bar[XB_XCNT(b.x)], 1u);
    return b;
}
__device__ __forceinline__ void xcd_barrier_complete(unsigned* bar, unsigned x, unsigned& nloc, unsigned& nx) {
    const unsigned G = gridDim.x * gridDim.y * gridDim.z;
    unsigned sum, cnt, mine, sp = 0u;
    for (;;) {
        sum = 0u; cnt = 0u; mine = 0u;
#pragma unroll
        for (unsigned j = 0; j < 16; ++j) { const unsigned c = xb_ld(&bar[XB_XCNT(j)]); sum += c; cnt += (c > 0u) ? 1u : 0u; mine = (j == x) ? c : mine; }
        if (sum == G) break;
        __builtin_amdgcn_s_sleep(1);
        if ((++sp & 255u) == 0u) { if (xb_ld(&bar[XB_TMO])) break; if (sp > XB_SPIN_CAP) { atomicAdd(&bar[XB_TMO], 1u); break; } }
    }
    nloc = mine > 0u ? mine : 1u; nx = cnt > 0u ? cnt : 1u;
}
__device__ __forceinline__ void xcd_barrier(const XcdBarrier& b, bool leader) {
    asm volatile("s_waitcnt vmcnt(0)" ::: "memory");
    __syncthreads();
    if (leader) {
        unsigned* bar = b.bar;
        __builtin_amdgcn_s_waitcnt(0);
        unsigned nloc = b.st[0], nx = b.st[1];
        if (nloc == 0u) { xcd_barrier_complete(bar, b.x, nloc, nx); b.st[0] = nloc; b.st[1] = nx; }
        const unsigned old = xb_add(&bar[XB_XSUB(b.x)], 1u);
        const unsigned gen = old / nloc;
        if (old + 1u == (gen + 1u) * nloc) {
            __builtin_amdgcn_fence(__ATOMIC_RELEASE, "agent");
            asm volatile("s_waitcnt vmcnt(0)" ::: "memory");
            const unsigned og = xb_add(&bar[XB_TOP], 1u);
            const unsigned tg = og / nx;
            if (og + 1u == (tg + 1u) * nx) xb_add(&bar[XB_TOPGEN], 1u);
            else XB_SPIN(xb_ld(&bar[XB_TOPGEN]) == tg, bar);
            __builtin_amdgcn_fence(__ATOMIC_ACQUIRE, "agent");
            xb_add(&bar[XB_XGEN(b.x)], 1u);
            asm volatile("s_waitcnt vmcnt(0)" ::: "memory");
        } else {
            XB_SPIN(xb_ld(&bar[XB_XGEN(b.x)]) == gen, bar);
            __builtin_amdgcn_fence(__ATOMIC_ACQUIRE, "agent");
            asm volatile("s_waitcnt vmcnt(0)" ::: "memory");
        }
    }
    __syncthreads();
}

#ifndef PROBE_MASK
#define PROBE_MASK 0
#endif
#define REP(bit) _Pragma("unroll") for (int rep_ = 0; rep_ < (((PROBE_MASK) >> (bit)) & 1) + 1; ++rep_)
#define GSYNC() do { PHASE_BEGIN(); xcd_barrier(xbar, tid == 0); if ((PROBE_MASK) & 1) xcd_barrier(xbar, tid == 0); } while (0)
__global__ void __launch_bounds__(512, 2) mega_fwd(Args a) {
    extern __shared__ __attribute__((aligned(16))) unsigned char lds_raw[];
    LAS unsigned char* lds = (LAS unsigned char*)lds_raw;
    cg::grid_group grid = cg::this_grid();
    const int wave0 = __builtin_amdgcn_readfirstlane((int)threadIdx.x >> 6);
    int tid, lane, wave, gtid, gw, G, bx, vcu, nthr, NGW;
#define REFRESH_TID() do { asm volatile("v_mbcnt_lo_u32_b32 %0, -1, 0\n\tv_mbcnt_hi_u32_b32 %0, -1, %0" : "=v"(lane)); wave = wave0; tid = wave * 64 + lane; \
        G = gridDim.x; bx = blockIdx.x; asm volatile("" : "+s"(G), "+s"(bx)); vcu = (G % 8 == 0) ? (bx % 8) * (G / 8) + bx / 8 : bx; nthr = G * 512; NGW = G * 8; gtid = bx * 512 + tid; gw = vcu * 8 + wave; } while (0)
    REFRESH_TID();
    typedef const Args __attribute__((address_space(4))) KArgs;
    KArgs* kap;
    unsigned char* ws; const float* x_in; float* xout;
#define PHASE_BEGIN() do { REFRESH_TID(); kap = (KArgs*)__builtin_amdgcn_kernarg_segment_ptr(); asm volatile("" : "+s"(kap)); ws = kap->ws; x_in = kap->in[0]; xout = kap->out; } while (0)
#define KIN(k) (kap->in[k])
#define Wb ((bf16_t*)(ws + WS_W))
#define ROPE ((float2*)(ws + WS_ROPE))
#define SSQ ((float*)(ws + WS_SSQ))
#define XN ((bf16_t*)(ws + WS_XN))
#define PROJ ((bf16_t*)(ws + WS_PROJ))
#define GATES ((bf16_t*)(ws + WS_GATES))
#define Qb ((bf16_t*)(ws + WS_Q))
#define KN ((bf16_t*)(ws + WS_KN))
#define VT ((bf16_t*)(ws + WS_VT))
#define KR ((bf16_t*)(ws + WS_KR))
#define AO ((bf16_t*)(ws + WS_AO))
#define PB ((bf16_t*)(ws + WS_PB))
#define SC ((bf16_t*)(ws + WS_SC))
#define CD ((bf16_t*)(ws + WS_CD))
#define MERGED ((bf16_t*)(ws + WS_MERGED))
#define Yb ((bf16_t*)(ws + WS_Y))
#define Hb ((bf16_t*)(ws + WS_H))
    PHASE_BEGIN();
    if (tid < 2) ((volatile LAS unsigned*)(lds + 131072))[tid] = 0u;
    __syncthreads();
    const XcdBarrier xbar = xcd_barrier_post((unsigned*)(ws + WS_CTL), (volatile LAS unsigned*)(lds + 131072), tid == 0);
    {
    const float *w_in = KIN(1), *g_pre_mix = KIN(2), *g_cq = KIN(3), *g_ckv = KIN(4), *w_uq = KIN(5), *w_ukv = KIN(6), *pool_w = KIN(7), *pool_scale = KIN(8),
                *w_br_a = KIN(13), *w_br_b = KIN(14), *w_br_c = KIN(15), *w_br_d = KIN(16),
                *w_out = KIN(17), *w_ffn_gate = KIN(20), *w_ffn_up = KIN(21), *w_ffn_down = KIN(22);

    for (int l = 0; l < DEPTH; ++l) {
        bf16_t* Wp = Wb + (size_t)l * W_LAYER;
        conv_weight<1>(w_in + (size_t)l * D * INW, D, INW, Wp + W_IN, 6144, 1024, nullptr, gtid, nthr);
        conv_weight<2>(w_uq + (size_t)l * 256 * 768, 256, 768, Wp + W_UQ, 768, 256, g_cq + l * 256, gtid, nthr);
        conv_weight<3>(w_ukv + (size_t)l * 128 * 1024, 128, 1024, Wp + W_K, 512, 256, g_ckv + l * 128, gtid, nthr);
        conv_weight<4>(w_ukv + (size_t)l * 128 * 1024, 128, 1024, Wp + W_V, 512, 256, g_ckv + l * 128, gtid, nthr);
        conv_weight<0>(w_br_a + (size_t)l * 512 * 1024, 512, 1024, Wp + W_BA, 1024, 512, nullptr, gtid, nthr);
        conv_pool(pool_w + (size_t)l * 4 * 64 * 64, pool_scale + l * 256, w_br_b + (size_t)l * 256 * 1024, Wp + W_BB, gtid, nthr);
        conv_weight<0>(w_br_c + (size_t)l * 256 * 1024, 256, 1024, Wp + W_BC, 1024, 256, nullptr, gtid, nthr);
        conv_weight<0>(w_br_d + (size_t)l * 256 * 1024, 256, 1024, Wp + W_BD, 1024, 256, nullptr, gtid, nthr);
        conv_weight<0>(w_out + (size_t)l * D * D, D, D, Wp + W_OUT, 1024, 1024, nullptr, gtid, nthr);
        conv_gu(w_ffn_gate + (size_t)l * D * DFF, w_ffn_up + (size_t)l * D * DFF, Wp + W_GU, gtid, nthr);
        conv_weight<0>(w_ffn_down + (size_t)l * DFF * D, DFF, D, Wp + W_DN, 1024, DFF, nullptr, gtid, nthr);
    }
    { const float* sw = KIN(10); bf16_t* w16 = (bf16_t*)(ws + WS_SGUW);
      for (int it = gtid; it < DEPTH * 4 * 128 * 128 / 2; it += nthr) { const float2 v = *(const float2*)(sw + 2 * it); *(unsigned*)(w16 + 2 * it) = cvt_pk_bf16(v.x, v.y); } }
    for (int it = gtid; it < SEQ * 16; it += nthr) { const int pos = it >> 4, i = it & 15;
        const float inv = powf(10000.0f, -(float)(2 * i) / 32.0f); const float ang = (float)pos * inv; ROPE[it] = make_float2(cosf(ang), sinf(ang)); }
    for (int r = gw; r < MG; r += NGW) norm_row(x_in + (size_t)r * D, g_pre_mix, XN + (size_t)r * D, lane);
    }
    grid.sync();

    for (int grp = 0; grp < NGRP; ++grp) {
        const size_t rowbase = (size_t)grp * MG;
        for (int l = 0; l < DEPTH; ++l) {
#define Wl (Wb + (size_t)l * W_LAYER)
            REP(1) { PHASE_BEGIN();
            { pg8::Gemm g{XN, Wl + W_IN, MG, 6144, 1024, 1024, 1024}; pg8::StaticOrder S; S.init(MG, 6144, G, bx);
              EpiInproj E{PROJ, GATES, SSQ}; pg8::gemm_phase<EpiInproj, true>(lds, g, S, E, tid); } }
            GSYNC();
            REP(3) { PHASE_BEGIN();
            { pg8::Gemm g{PROJ, Wl + W_UQ, MG, 768, 256, 2048, 256}; pg8::StaticOrder S; S.init(MG, 768, G, bx);
              EpiUq E{Qb, SSQ, ROPE}; pg8::gemm_phase<EpiUq, true>(lds, g, S, E, tid); }
            REFRESH_TID();
            { pg8::Gemm g{PROJ + 256, Wl + W_K, MG, 512, 256, 2048, 256}; pg8::StaticOrder S; S.init(MG, 512, G, (bx + 64) % G);
              EpiUk E{KN, SSQ}; pg8::gemm_phase<EpiUk, true>(lds, g, S, E, tid); }
            REFRESH_TID();
            { pg8::Gemm g{Wl + W_V, PROJ + 256, 512, MG, 256, 256, 2048}; pg8::StaticOrder S; S.init(512, MG, G, (bx + 128) % G);
              EpiUv E{VT, SSQ}; pg8::gemm_phase<EpiUv, true>(lds, g, S, E, tid); }
            PHASE_BEGIN();
            {
                const float* cw = KIN(12) + (size_t)l * 3 * 256;
                for (int it = gtid; it < (MG / 16) * 64; it += nthr) {
                    const int rr = it >> 6, c = it & 63, row0 = rr * 16, t0 = row0 & (SEQ - 1);
                    if (c < 32) {
                        const int w = 2 << (c >> 3); const int n0 = (t0 + 1 < w) ? (t0 + 1) : w;
                        const bf16_t* zp = PROJ + (size_t)row0 * 2048 + 512 + c * 8;
                        f32x4 s0 = {0.f, 0.f, 0.f, 0.f}, s1 = s0;
                        for (int k = 1; k < n0; ++k) { f32x4 a0, a1; unpack8(*(const u32x4*)(zp - (size_t)k * 2048), a0, a1); s0 = s0 + a0; s1 = s1 + a1; }
#pragma unroll 4
                        for (int i = 0; i < 16; ++i) { const int t = t0 + i;
                            f32x4 z0, z1; unpack8(*(const u32x4*)(zp + (size_t)i * 2048), z0, z1); s0 = s0 + z0; s1 = s1 + z1;
                            const int n = (t + 1 < w) ? (t + 1) : w; const float inv = 1.f / (float)n;
                            *(u32x4*)(PB + (size_t)(row0 + i) * 256 + c * 8) = pack8(s0 * inv - z0, s1 * inv - z1);
                            if (t + 1 - w >= 0) { f32x4 a0, a1; unpack8(*(const u32x4*)(zp + (ptrdiff_t)(i + 1 - w) * 2048), a0, a1); s0 = s0 - a0; s1 = s1 - a1; } }
                    } else if (c < 64) {
                        const int cc = (c - 32) * 8; const bf16_t* pr = PROJ + (size_t)row0 * 2048;
                        const f32x4 w0a = *(const f32x4*)(cw + cc), w0b = *(const f32x4*)(cw + cc + 4), w1a = *(const f32x4*)(cw + 256 + cc), w1b = *(const f32x4*)(cw + 256 + cc + 4),
                                    w2a = *(const f32x4*)(cw + 512 + cc), w2b = *(const f32x4*)(cw + 512 + cc + 4);
                        f32x4 m2a = {0.f, 0.f, 0.f, 0.f}, m2b = m2a, m1a = m2a, m1b = m2a;
                        if (t0 >= 2) { f32x4 c0, c1, x0, x1; unpack8(*(const u32x4*)(pr - 2 * 2048 + 1536 + cc), c0, c1); unpack8(*(const u32x4*)(pr - 2 * 2048 + 1792 + cc), x0, x1); m2a = c0 * x0; m2b = c1 * x1; }
                        if (t0 >= 1) { f32x4 c0, c1, x0, x1; unpack8(*(const u32x4*)(pr - 2048 + 1536 + cc), c0, c1); unpack8(*(const u32x4*)(pr - 2048 + 1792 + cc), x0, x1); m1a = c0 * x0; m1b = c1 * x1; }
#pragma unroll 4
                        for (int i = 0; i < 16; ++i) { const bf16_t* p = pr + (size_t)i * 2048;
                            f32x4 c0, c1, x0, x1, b0, b1; unpack8(*(const u32x4*)(p + 1536 + cc), c0, c1); unpack8(*(const u32x4*)(p + 1792 + cc), x0, x1); unpack8(*(const u32x4*)(p + 1280 + cc), b0, b1);
                            const f32x4 za = c0 * x0, zb = c1 * x1;
                            const f32x4 ya = w0a * m2a + w1a * m1a + w2a * za, yb = w0b * m2b + w1b * m1b + w2b * zb;
                            *(u32x4*)(CD + (size_t)(row0 + i) * 256 + cc) = pack8(b0 * ya, b1 * yb);
                            m2a = m1a; m2b = m1b; m1a = za; m1b = zb; }
                    }
                }
                for (int it = gtid; it < MG * 4; it += nthr) {
                    const int row = it >> 2, j = it & 3, t = row & (SEQ - 1); const bf16_t* pr = PROJ + (size_t)row * 2048 + 384;
                    const u32x2 a = *(const u32x2*)(pr + 4 * j), b2 = *(const u32x2*)(pr + 16 + 4 * j);
                    const float x1[4] = {bflo(a.x), bfhi(a.x), bflo(a.y), bfhi(a.y)}, x2[4] = {bflo(b2.x), bfhi(b2.x), bflo(b2.y), bfhi(b2.y)};
                    f32x4 o0, o1;
#pragma unroll
                    for (int q = 0; q < 4; ++q) { const float2 cs = ROPE[t * 16 + 4 * j + q]; const float r1 = x1[q] * cs.x - x2[q] * cs.y, r2 = x2[q] * cs.x + x1[q] * cs.y;
                        if (q < 2) { o0[2 * q] = r1; o0[2 * q + 1] = r2; } else { o1[2 * (q - 2)] = r1; o1[2 * (q - 2) + 1] = r2; } }
                    const int seq = row >> 11, kt = t >> 6, jj = (t >> 5) & 1, r32 = t & 31;
                    *(u32x4*)(KR + ((size_t)(((seq * 32 + kt) * 2 + (j >> 1)) * 2 + jj) * 64 + (j & 1) * 32 + r32) * 8) = pack8(o0, o1);
                }
            }
            PHASE_BEGIN();
            {
                LAS bf16_t* VnT = (LAS bf16_t*)lds;
                const bf16_t* W16 = (const bf16_t*)(ws + WS_SGUW) + (size_t)l * 65536; const float* sb = KIN(11) + (size_t)l * 4 * 128; const float* gv = KIN(9) + (size_t)l * 256;
                const int r32 = lane & 31, hi = lane >> 5, itile = wave >> 1, ct = wave & 1;
                for (int un = bx; un < (MG / 128) * 4; un += G) {
                    const int nb = un >> 2, g = un & 3; const int row0 = nb * 128;
                    __syncthreads();
                    for (int i = tid; i < 1024; i += 512) { const int j = i & 127, c8 = (i >> 7) * 8; const int row = row0 + j;
                        const float rs = rstd_from(SSQ, 2, row, 1.f / 256.f);
                        f32x4 v0, v1; unpack8(*(const u32x4*)(PROJ + (size_t)row * 2048 + 1024 + g * 64 + c8), v0, v1);
                        const f32x4 g0 = *(const f32x4*)(gv + g * 64 + c8), g1 = *(const f32x4*)(gv + g * 64 + c8 + 4);
                        v0 = v0 * rs * g0; v1 = v1 * rs * g1;
                        const unsigned p0 = cvt_pk_bf16(v0[0], v0[1]), p1 = cvt_pk_bf16(v0[2], v0[3]), p2 = cvt_pk_bf16(v1[0], v1[1]), p3 = cvt_pk_bf16(v1[2], v1[3]);
                        LAS bf16_t* d = VnT + c8 * 136 + j;
                        d[0] = (bf16_t)(p0 & 0xffffu); d[136] = (bf16_t)(p0 >> 16); d[2 * 136] = (bf16_t)(p1 & 0xffffu); d[3 * 136] = (bf16_t)(p1 >> 16);
                        d[4 * 136] = (bf16_t)(p2 & 0xffffu); d[5 * 136] = (bf16_t)(p2 >> 16); d[6 * 136] = (bf16_t)(p3 & 0xffffu); d[7 * 136] = (bf16_t)(p3 >> 16); }
                    __syncthreads();
                    f32x16 acc = {};
                    const bf16_t* wp = W16 + (size_t)g * 16384 + (32 * itile + r32) * 128 + hi * 8;
                    const LAS bf16_t* bp = VnT + (32 * ct + r32) * 136 + hi * 8;
#pragma unroll
                    for (int ks = 0; ks < 8; ++ks) if (ks < 4 || itile >= 2)
                        acc = __builtin_amdgcn_mfma_f32_32x32x16_bf16(*(const s16x8*)(wp + ks * 16), *(const LAS s16x8*)(bp + ks * 16), acc, 0, 0, 0);
                    const int c = 32 * ct + r32;
#pragma unroll
                    for (int r = 0; r < 16; ++r) { const int i = 32 * itile + (r & 3) + 8 * (r >> 2) + 4 * hi; const int row = row0 + i;
                        const float uu = bflo((unsigned)PROJ[(size_t)row * 2048 + 768 + g * 64 + c]);
                        const float o = uu * (acc[r] + sb[g * 128 + i]);
                        SC[(size_t)row * 256 + g * 64 + c] = (bf16_t)(cvt_pk_bf16(o, 0.f) & 0xffffu); }
                }
                __syncthreads();
            } }
            GSYNC();
            REP(2) { PHASE_BEGIN();
            for (int wu = gw; wu < GSEQ * 8 * 16; wu += NGW) {
                const int bh = wu >> 4, qc = wu & 15;
                attn_unit64(Qb, KN, KR, VT, AO, bh >> 3, bh & 7, qc, lane, lds + wave * 12288);
                attn_unit64(Qb, KN, KR, VT, AO, bh >> 3, bh & 7, 31 - qc, lane, lds + wave * 12288);
            } }
            GSYNC();
            REP(4) { PHASE_BEGIN();
            { pg8::StaticOrder S; S.init(MG, 1024, G, bx);
              { pg8::Gemm g{AO, Wl + W_BA, MG, 1024, 512, 512, 512}; EpiGate E{MERGED, GATES, 0}; pg8::gemm_phase<EpiGate, true>(lds, g, S, E, tid); }
              for (int b = 1; b < 4; ++b) { REFRESH_TID(); const bf16_t* Ab = (b == 1) ? PB : (b == 2) ? SC : CD; const bf16_t* Wbb = Wl + ((b == 1) ? W_BB : (b == 2) ? W_BC : W_BD);
                pg8::Gemm g{Ab, Wbb, MG, 1024, 256, 256, 256}; EpiGate E{MERGED, GATES, b}; pg8::gemm_phase<EpiGate, true>(lds, g, S, E, tid); } } }
            GSYNC();
            REP(1) { PHASE_BEGIN();
            { pg8::Gemm g{MERGED, Wl + W_OUT, MG, 1024, 1024, 1024, 1024}; pg8::StaticOrder S; S.init(MG, 1024, G, bx);
              EpiPlain E{Yb, 1024}; pg8::gemm_phase<EpiPlain, true>(lds, g, S, E, tid); } }
            GSYNC();
            PHASE_BEGIN();
            { const float* xs = (l == 0) ? x_in : xout;
              for (int r = gw; r < MG; r += NGW) resid_row(xs + (rowbase + r) * D, Yb + (size_t)r * D, KIN(18) + l * D, xout + (rowbase + r) * D, KIN(19) + l * D, XN + (size_t)r * D, lane); }
            GSYNC();
            REP(1) { PHASE_BEGIN();
            { pg8::Gemm g{XN, Wl + W_GU, MG, 5632, 1024, 1024, 1024}; pg8::StaticOrder S; S.init(MG, 5632, G, bx);
              EpiSwiglu E{Hb}; pg8::gemm_phase<EpiSwiglu, true>(lds, g, S, E, tid); } }
            GSYNC();
            REP(1) { PHASE_BEGIN();
            { pg8::Gemm g{Hb, Wl + W_DN, MG, 1024, DFF, DFF, DFF}; pg8::StaticOrder S; S.init(MG, 1024, G, bx);
              EpiPlain E{Yb, 1024}; pg8::gemm_phase<EpiPlain, true>(lds, g, S, E, tid); } }
            GSYNC();
            PHASE_BEGIN();
            { const float* gn = (l + 1 < DEPTH) ? KIN(2) + (l + 1) * D : nullptr;
              for (int r = gw; r < MG; r += NGW) resid_row(xout + (rowbase + r) * D, Yb + (size_t)r * D, KIN(23) + l * D, xout + (rowbase + r) * D, gn, XN + (size_t)r * D, lane);
              if (l + 1 == DEPTH && grp + 1 < NGRP) for (int r = gw; r < MG; r += NGW) norm_row(x_in + (rowbase + MG + r) * D, KIN(2), XN + (size_t)r * D, lane); }
            GSYNC();
        }
    }
}

extern "C" void kernel_launch(void* const* d_in, const int* in_sizes, int n_in, void* d_out, int out_size, void* d_ws, size_t ws_size, hipStream_t stream) {
    static int grid = 0;
    if (grid == 0) {
        if (n_in != 24 || ws_size < WS_END) { fprintf(stderr, "kernel_launch: unexpected inputs (n_in %d, ws %zu)\n", n_in, ws_size); grid = -1; return; }
        int dev = 0, cus = 0, per_cu = 0;
        hipGetDevice(&dev); hipDeviceGetAttribute(&cus, hipDeviceAttributeMultiprocessorCount, dev);
        hipFuncSetAttribute((const void*)mega_fwd, hipFuncAttributeMaxDynamicSharedMemorySize, LDS_BYTES);
        if (hipOccupancyMaxActiveBlocksPerMultiprocessor(&per_cu, (const void*)mega_fwd, 512, LDS_BYTES) != hipSuccess || per_cu < 1) { fprintf(stderr, "kernel_launch: occupancy query says %d\n", per_cu); per_cu = 1; }
        (void)hipGetLastError();
        grid = cus * 1;
    }
    if (grid < 0) return;
    if (hipMemsetAsync((char*)d_ws + WS_CTL, 0, CTL_ZERO_BYTES, stream) != hipSuccess) { fprintf(stderr, "kernel_launch: memset failed\n"); return; }
    Args a{};
    for (int i = 0; i < 24; ++i) a.in[i] = (const float*)d_in[i];
    a.out = (float*)d_out; a.ws = (unsigned char*)d_ws;
    void* args[] = {&a};
    hipError_t e = hipLaunchCooperativeKernel((const void*)mega_fwd, dim3(grid), dim3(512), args, LDS_BYTES, stream);
    if (e != hipSuccess) fprintf(stderr, "cooperative launch failed: %s (grid %d)\n", hipGetErrorString(e), grid);
}
```
